# Optimizing an MI355X kernel written in HIP

```python
import jax, jax.numpy as jnp
from jax import lax
import numpy as np

D_MODEL = 2048
BATCH = 8
SEQ = 4096
DEPTH = 4

MIX_WIDTH = D_MODEL
GROUP_WIDTH = MIX_WIDTH // 4
HEAD_DIM = 128
N_HEADS_PER_MIXER = GROUP_WIDTH // HEAD_DIM
CHUNK = 128
SHORT_CONV = 3
CONFORMER_CONV = 31
POOL_WINDOWS = (2, 4, 8, 16)
POOL_GROUP = GROUP_WIDTH // len(POOL_WINDOWS)
D_FF = ((8 * D_MODEL // 3 + 255) // 256) * 256
PLE_DIM = 256
EPS = 1e-6
A_COLS = 2 * GROUP_WIDTH
B_COLS = 3 * GROUP_WIDTH
C_COLS = 2 * GROUP_WIDTH
D_COLS = GROUP_WIDTH
IN_COLS = A_COLS + B_COLS + C_COLS + D_COLS

kernel_name = "hybrid_sgu_conv_conformer_pool_trunk"


def _rms(x, g):
    xf = x.astype(jnp.float32)
    y = xf * lax.rsqrt(jnp.mean(xf * xf, axis=-1, keepdims=True) + EPS)
    return (y * g.astype(jnp.float32)).astype(x.dtype)


def _ln(x, g, b):
    xf = x.astype(jnp.float32)
    mu = jnp.mean(xf, axis=-1, keepdims=True)
    xc = xf - mu
    var = jnp.mean(xc * xc, axis=-1, keepdims=True)
    y = xc * lax.rsqrt(var + EPS) * g.astype(jnp.float32) + b.astype(jnp.float32)
    return y.astype(x.dtype)


def _causal_dwconv(x, w):
    k, c = w.shape
    return lax.conv_general_dilated(
        x, w[:, None, :].astype(x.dtype), window_strides=(1,), padding=[(k - 1, 0)],
        dimension_numbers=("NWC", "WIO", "NWC"), feature_group_count=c)


def _mixer_sgu(z, ln_g, ln_b, w_s, b_s):
    bsz, s, _ = z.shape
    n = s // CHUNK
    z = jax.nn.gelu(z)
    u, v = jnp.split(z, 2, axis=-1)
    v = _ln(v.reshape(bsz, s, N_HEADS_PER_MIXER, HEAD_DIM), ln_g, ln_b)
    v = v.reshape(bsz, n, CHUNK, N_HEADS_PER_MIXER, HEAD_DIM)
    mask = jnp.tril(jnp.ones((CHUNK, CHUNK), dtype=bool))
    wm = jnp.where(mask[None], w_s, jnp.zeros((), w_s.dtype))
    sp = jnp.einsum("hts,bnshd->bnthd", wm, v) + b_s.T[:, :, None]
    out = u.reshape(bsz, n, CHUNK, N_HEADS_PER_MIXER, HEAD_DIM) * sp
    return out.reshape(bsz, s, GROUP_WIDTH)


def _mixer_shortconv(z, conv_w):
    h, bg, cg = jnp.split(z, 3, axis=-1)
    return bg * _causal_dwconv(cg * h, conv_w)


def _mixer_conformer(z, conv_w, conv_b, ln_g, ln_b):
    a, g = jnp.split(z, 2, axis=-1)
    h = a * jax.nn.sigmoid(g)
    h = _causal_dwconv(h, conv_w) + conv_b
    h = _ln(h, ln_g, ln_b)
    return jax.nn.silu(h)


def _mixer_pool(z, pool_w, pool_scale):
    bsz, s, _ = z.shape
    zg = z.reshape(bsz, s, len(POOL_WINDOWS), POOL_GROUP)
    cs = jnp.cumsum(zg.astype(jnp.float32), axis=1)
    pos = jnp.arange(1, s + 1, dtype=jnp.int32)
    pooled = []
    for gi, w in enumerate(POOL_WINDOWS):
        c = cs[:, :, gi]
        lagged = jnp.pad(c, ((0, 0), (w, 0), (0, 0)))[:, :s]
        count = jnp.minimum(pos, w).astype(jnp.float32)
        pooled.append((c - lagged) / count[None, :, None])
    pooled = jnp.stack(pooled, axis=2).astype(z.dtype) - zg
    out = jnp.einsum("bsgc,gcd->bsgd", pooled, pool_w).reshape(bsz, s, GROUP_WIDTH)
    return out * pool_scale


def setup_inputs(seed: int = 0) -> dict:
    key = jax.random.key(seed)
    ks = jax.random.split(key, 24)
    f = jnp.float32
    L, D, G, H, hd = DEPTH, D_MODEL, GROUP_WIDTH, N_HEADS_PER_MIXER, HEAD_DIM
    nrm = lambda k, shape, scale: jax.random.normal(k, shape, f) * scale
    gain = lambda k, shape: 1.0 + 0.05 * jax.random.normal(k, shape, f)
    return {
        "x": jax.random.normal(ks[0], (BATCH, SEQ, D), f),
        "p": jax.random.normal(ks[1], (DEPTH, BATCH, SEQ, PLE_DIM), f),
        "norm_mix_g": gain(ks[2], (L, D)),
        "w_in": nrm(ks[3], (L, D, IN_COLS), D ** -0.5),
        "sgu_ln_g": gain(ks[4], (L, H, hd)),
        "sgu_ln_b": nrm(ks[5], (L, H, hd), 0.02),
        "sgu_w": nrm(ks[6], (L, H, CHUNK, CHUNK), CHUNK ** -0.5),
        "sgu_b": gain(ks[7], (L, H, CHUNK)),
        "sc_conv_w": nrm(ks[8], (L, SHORT_CONV, G), SHORT_CONV ** -0.5),
        "cf_conv_w": nrm(ks[9], (L, CONFORMER_CONV, G), CONFORMER_CONV ** -0.5),
        "cf_conv_b": nrm(ks[10], (L, G), 0.02),
        "cf_ln_g": gain(ks[11], (L, G)),
        "cf_ln_b": nrm(ks[12], (L, G), 0.02),
        "pool_w": nrm(ks[13], (L, len(POOL_WINDOWS), POOL_GROUP, POOL_GROUP), POOL_GROUP ** -0.5),
        "pool_scale": 0.5 + 0.1 * jax.random.normal(ks[14], (L, G), f),
        "w_out": nrm(ks[15], (L, MIX_WIDTH, D), MIX_WIDTH ** -0.5),
        "norm_ffn_g": gain(ks[16], (L, D)),
        "w_gate": nrm(ks[17], (L, D, D_FF), D ** -0.5),
        "w_up": nrm(ks[18], (L, D, D_FF), D ** -0.5),
        "w_down": nrm(ks[19], (L, D_FF, D), D_FF ** -0.5),
        "norm_ple_g": gain(ks[20], (L, D)),
        "w_ple_gate": nrm(ks[21], (L, D, D), D ** -0.5),
        "w_ple_proj": nrm(ks[22], (L, PLE_DIM, D), PLE_DIM ** -0.5),
        "final_norm_g": gain(ks[23], (D,)),
    }


def reference(x, p, norm_mix_g, w_in, sgu_ln_g, sgu_ln_b, sgu_w, sgu_b, sc_conv_w,
              cf_conv_w, cf_conv_b, cf_ln_g, cf_ln_b, pool_w, pool_scale, w_out,
              norm_ffn_g, w_gate, w_up, w_down, norm_ple_g, w_ple_gate, w_ple_proj,
              final_norm_g):
    h = x
    split_at = [A_COLS, A_COLS + B_COLS, A_COLS + B_COLS + C_COLS]
    for i in range(DEPTH):
        y = _rms(h, norm_mix_g[i])
        z = y @ w_in[i]
        za, zb, zc, zd = jnp.split(z, split_at, axis=-1)
        oa = _mixer_sgu(za, sgu_ln_g[i], sgu_ln_b[i], sgu_w[i], sgu_b[i])
        ob = _mixer_shortconv(zb, sc_conv_w[i])
        oc = _mixer_conformer(zc, cf_conv_w[i], cf_conv_b[i], cf_ln_g[i], cf_ln_b[i])
        od = _mixer_pool(zd, pool_w[i], pool_scale[i])
        h = h + jnp.concatenate([oa, ob, oc, od], axis=-1) @ w_out[i]
        y = _rms(h, norm_ffn_g[i])
        h = h + (jax.nn.silu(y @ w_gate[i]) * (y @ w_up[i])) @ w_down[i]
        y = _rms(h, norm_ple_g[i])
        h = h + jax.nn.sigmoid(y @ w_ple_gate[i]) * (p[i] @ w_ple_proj[i])
    return _rms(h, final_norm_g)
```

```cpp
#include <hip/hip_runtime.h>
#include <cstdio>
#include <cstdint>

#ifndef PROBE_DUP
#define PROBE_DUP 0
#endif
#ifndef MK_N_LAUNCHES
#define MK_N_LAUNCHES 1
#endif

namespace pg8 {
#define PG8_LAS __attribute__((address_space(3)))
typedef unsigned short bf16_t;
typedef short bf16x8 __attribute__((ext_vector_type(8)));
typedef float f32x4 __attribute__((ext_vector_type(4)));
typedef unsigned u32x4 __attribute__((ext_vector_type(4)));
typedef unsigned u32x2 __attribute__((ext_vector_type(2)));
constexpr int BM = 256, BK = 64, HALF = 128, HTB = HALF * BK * 2  , STAGE_BYTES = 8 * HTB, NXCD = 8, WGM = 8;
constexpr int RS_OFF = STAGE_BYTES;

__host__ __device__ __forceinline__ int lds_byte(int r, int c) { const int st = (r >> 4) * 2 + (c >> 5), rr = r & 15, cc = c & 31, ob = rr * 64 + cc * 2; return st * 1024 + (ob ^ (((ob >> 9) & 1) << 5)); }
__host__ __device__ __forceinline__ void stage_rc(int b, int& R, int& C) { const int st = b / 1024, sb = b % 1024, swz = sb ^ (((sb >> 9) & 1) << 5); R = (st >> 1) * 16 + swz / 64; C = (st & 1) * 32 + (swz % 64) / 2; }
__host__ __device__ __forceinline__ int perm32(int rho) { const int n = rho >> 4, i = rho & 15; return 8 * (i >> 2) + 4 * n + (i & 3); }

struct Unit { int pm, pn; int lm, ln; };
struct Gemm { const bf16_t* A; const bf16_t* Bt; int M, N, K; };

struct StaticOrder {
    int nM, nN, nwg, G, c, wgm, fixed = 0, rev = 0;
    __host__ __device__ void init(int M, int N, int G_, int c_, int wgm_ = WGM) { nM = M / BM; nN = N / BM; nwg = nM * nN; G = G_; c = c_; wgm = wgm_; }
    __host__ __device__ bool next(int i, Unit& u) const {
        if ((long)i * G + c >= nwg) return false;
        const long L = rev ? (long)((nwg - 1 - c) / G - i) * G + c : (long)i * G + c;
        int wgid = (int)L; { const int q = nwg / NXCD, r = nwg % NXCD, xcd = wgid % NXCD, off = wgid / NXCD; wgid = (xcd < r ? xcd * (q + 1) : r * (q + 1) + (xcd - r) * q) + off; }
        const int nig = wgm * nN, gid = wgid / nig, fm = gid * wgm, gsz = (nM - fm) < wgm ? (nM - fm) : wgm;
        u.pm = fm + ((wgid % nig) % gsz); u.pn = (wgid % nig) / gsz; u.lm = fixed ? 0 : u.pm; u.ln = fixed ? 0 : u.pn; return true;
    }
    __device__ __forceinline__ void a_ready(const Unit&) const {}
    __device__ __forceinline__ void done(const Unit&) const {}
};

struct FixedOrder : StaticOrder {
    __host__ __device__ bool next(int i, Unit& u) const { const bool ok = StaticOrder::next(i, u); u.lm = 0; u.ln = 0; return ok; }
};
typedef __bf16 bf16x2_t __attribute__((ext_vector_type(2)));
typedef float f32x2_t __attribute__((ext_vector_type(2)));
__device__ __forceinline__ unsigned cvt_pk_bf16(float lo, float hi) { return __builtin_bit_cast(unsigned, __builtin_convertvector((f32x2_t){lo, hi}, bf16x2_t)); }
__device__ __forceinline__ float sigmoid_f(float x) { return __builtin_amdgcn_rcpf(1.0f + __builtin_amdgcn_exp2f(-1.4426950408889634f * x)); }
__device__ __forceinline__ float silu_f(float x) { return x * sigmoid_f(x); }
__device__ __forceinline__ float gelu_f(float x) { return x * sigmoid_f(1.5957691216057308f * (x + 0.044715f * x * x * x)); }
__device__ __forceinline__ float bf_lo(unsigned w) { return __uint_as_float(w << 16); }
__device__ __forceinline__ float bf_hi(unsigned w) { return __uint_as_float(w & 0xffff0000u); }

template <int CTRL> __device__ __forceinline__ float dpp_f(float v) { return __int_as_float(__builtin_amdgcn_update_dpp(0, __float_as_int(v), CTRL, 0xf, 0xf, true)); }
template <int PAT> __device__ __forceinline__ float swz_f(float v) { return __int_as_float(__builtin_amdgcn_ds_swizzle(__float_as_int(v), PAT)); }
__device__ __forceinline__ float sum_xor1_2(float v) { v += dpp_f<0xB1>(v); v += dpp_f<0x4E>(v); return v; }
__device__ __forceinline__ float sum_xor16(float v) { return v + swz_f<0x401F>(v); }
__device__ __forceinline__ float sum_xor32(float v) { const auto r = __builtin_amdgcn_permlane32_swap(__float_as_uint(v), __float_as_uint(v), false, false); return __uint_as_float(r[0]) + __uint_as_float(r[1]); }
__device__ __forceinline__ float wave_sum_f(float v) { v = sum_xor1_2(v); v += dpp_f<0x124>(v); v += dpp_f<0x128>(v); v = sum_xor16(v); return sum_xor32(v); }

__device__ __forceinline__ void rs_prep(const float* ss, int pm, int parity, PG8_LAS unsigned char* lds, int tid) {
    if (tid < 256) {
        const f32x4* p = (const f32x4*)(ss + (size_t)(pm * BM + tid) * 32);
        f32x4 s = p[0];
#pragma unroll
        for (int j = 1; j < 8; ++j) s += p[j];
        const float tot = (s[0] + s[1]) + (s[2] + s[3]);
        *(PG8_LAS float*)(lds + RS_OFF + parity * 1024 + tid * 4) = __builtin_amdgcn_rsqf(tot * (1.0f / 2048.0f) + 1e-6f);
    }
    asm volatile("s_waitcnt lgkmcnt(0)" ::: "memory");
}
__device__ __forceinline__ void rs_load(float (&rs)[8], PG8_LAS unsigned char* lds, int parity, int wr, int fr) {
    const unsigned addr = (unsigned)(uintptr_t)(lds + RS_OFF + parity * 1024 + (wr * 64 + fr) * 4);
    asm volatile("ds_read_b32 %0, %8\n\tds_read_b32 %1, %8 offset:64\n\tds_read_b32 %2, %8 offset:128\n\tds_read_b32 %3, %8 offset:192\n\t"
                 "ds_read_b32 %4, %8 offset:512\n\tds_read_b32 %5, %8 offset:576\n\tds_read_b32 %6, %8 offset:640\n\tds_read_b32 %7, %8 offset:704\n\ts_waitcnt lgkmcnt(0)"
                 : "=&v"(rs[0]), "=&v"(rs[1]), "=&v"(rs[2]), "=&v"(rs[3]), "=&v"(rs[4]), "=&v"(rs[5]), "=&v"(rs[6]), "=&v"(rs[7]) : "v"(addr) : "memory");
}

template <bool SCALE> struct EpiStore {
    static constexpr bool PERM = true, AFTER_DRAIN = false, HAS_PREP = SCALE;
    bf16_t* O; int ldc; const float* ss;
    __device__ __forceinline__ void prep(const Unit& u, int parity, PG8_LAS unsigned char* lds, int tid) const { rs_prep(ss, u.pm, parity, lds, tid); }
    __device__ __forceinline__ void operator()(const f32x4 (&acc)[2][2][4][2], const Unit& u, int wr, int wc, int fr, int fq, PG8_LAS unsigned char* lds, int parity) const {
        float rs[8];
        if constexpr (SCALE) rs_load(rs, lds, parity, wr, fr);
        const int row0 = u.pm * BM + wr * 64 + fr, col0 = u.pn * BM + wc * 32 + 8 * fq;
#pragma unroll
        for (int ai = 0; ai < 2; ++ai)
#pragma unroll
            for (int m = 0; m < 4; ++m) { bf16_t* rowp = O + (size_t)(row0 + ai * HALF + m * 16) * ldc + col0; const float s = SCALE ? rs[ai * 4 + m] : 1.0f;
#pragma unroll
                for (int bj = 0; bj < 2; ++bj) { const f32x4 v0 = acc[ai][bj][m][0] * s, v1 = acc[ai][bj][m][1] * s;
                    u32x4 w; w.x = cvt_pk_bf16(v0[0], v0[1]); w.y = cvt_pk_bf16(v0[2], v0[3]); w.z = cvt_pk_bf16(v1[0], v1[1]); w.w = cvt_pk_bf16(v1[2], v1[3]);
                    *(u32x4*)(rowp + bj * HALF) = w; } }
    }
};
struct EpiG1 {
    static constexpr bool PERM = true, AFTER_DRAIN = false, HAS_PREP = true;
    bf16_t* O; const float* ss;
    static constexpr int LDO = 3072;
    __device__ __forceinline__ void prep(const Unit& u, int parity, PG8_LAS unsigned char* lds, int tid) const { rs_prep(ss, u.pm, parity, lds, tid); }
    __device__ __forceinline__ void operator()(const f32x4 (&acc)[2][2][4][2], const Unit& u, int wr, int wc, int fr, int fq, PG8_LAS unsigned char* lds, int parity) const {
        float rs[8]; rs_load(rs, lds, parity, wr, fr);
        const int row0 = u.pm * BM + wr * 64 + fr, lc = wc * 32 + 8 * fq, pn = u.pn;
        const bool pair = (pn >= 4 && pn < 8) || (pn >= 10 && pn < 14);
        if (!pair) {
            const int col0 = (pn < 4 ? 256 * pn : pn < 10 ? 1536 + 256 * (pn - 8) : 2560 + 256 * (pn - 14)) + lc; const bool act = pn < 4;
#pragma unroll
            for (int ai = 0; ai < 2; ++ai)
#pragma unroll
                for (int m = 0; m < 4; ++m) { bf16_t* rowp = O + (size_t)(row0 + ai * HALF + m * 16) * LDO + col0; const float s = rs[ai * 4 + m];
#pragma unroll
                    for (int bj = 0; bj < 2; ++bj) { f32x4 v0 = acc[ai][bj][m][0] * s, v1 = acc[ai][bj][m][1] * s;
                        if (act) {
#pragma unroll
                            for (int j = 0; j < 4; ++j) { v0[j] = gelu_f(v0[j]); v1[j] = gelu_f(v1[j]); } }
                        u32x4 w; w.x = cvt_pk_bf16(v0[0], v0[1]); w.y = cvt_pk_bf16(v0[2], v0[3]); w.z = cvt_pk_bf16(v1[0], v1[1]); w.w = cvt_pk_bf16(v1[2], v1[3]);
                        *(u32x4*)(rowp + bj * HALF) = w; } }
        } else {
            const int col0 = (pn < 8 ? 1024 + 128 * (pn - 4) : 2048 + 128 * (pn - 10)) + lc; const bool glu = pn >= 10;
#pragma unroll
            for (int ai = 0; ai < 2; ++ai)
#pragma unroll
                for (int m = 0; m < 4; ++m) { bf16_t* rowp = O + (size_t)(row0 + ai * HALF + m * 16) * LDO + col0; const float s = rs[ai * 4 + m];
                    float o[8];
#pragma unroll
                    for (int n = 0; n < 2; ++n)
#pragma unroll
                        for (int j = 0; j < 4; ++j) { const float a = acc[ai][0][m][n][j] * s, b = acc[ai][1][m][n][j] * s; o[n * 4 + j] = a * (glu ? sigmoid_f(b) : b); }
                    u32x4 w; w.x = cvt_pk_bf16(o[0], o[1]); w.y = cvt_pk_bf16(o[2], o[3]); w.z = cvt_pk_bf16(o[4], o[5]); w.w = cvt_pk_bf16(o[6], o[7]);
                    *(u32x4*)rowp = w; }
        }
    }
};
struct EpiSwiGLU {
    static constexpr bool PERM = true, AFTER_DRAIN = false, HAS_PREP = true;
    bf16_t* T; int ldt; const float* ss;
    __device__ __forceinline__ void prep(const Unit& u, int parity, PG8_LAS unsigned char* lds, int tid) const { rs_prep(ss, u.pm, parity, lds, tid); }
    __device__ __forceinline__ void operator()(const f32x4 (&acc)[2][2][4][2], const Unit& u, int wr, int wc, int fr, int fq, PG8_LAS unsigned char* lds, int parity) const {
        float rs[8]; rs_load(rs, lds, parity, wr, fr);
        const int row0 = u.pm * BM + wr * 64 + fr, col0 = u.pn * HALF + wc * 32 + 8 * fq;
#pragma unroll
        for (int ai = 0; ai < 2; ++ai)
#pragma unroll
            for (int m = 0; m < 4; ++m) { bf16_t* rowp = T + (size_t)(row0 + ai * HALF + m * 16) * ldt + col0; const float s = rs[ai * 4 + m];
                float o[8];
#pragma unroll
                for (int n = 0; n < 2; ++n)
#pragma unroll
                    for (int j = 0; j < 4; ++j) { const float g = acc[ai][0][m][n][j] * s, uu = acc[ai][1][m][n][j] * s; o[n * 4 + j] = silu_f(g) * uu; }
                u32x4 w; w.x = cvt_pk_bf16(o[0], o[1]); w.y = cvt_pk_bf16(o[2], o[3]); w.z = cvt_pk_bf16(o[4], o[5]); w.w = cvt_pk_bf16(o[6], o[7]);
                *(u32x4*)rowp = w; }
    }
};
struct EpiRes {
    static constexpr bool PERM = true, AFTER_DRAIN = false, HAS_PREP = false;
    bf16_t* HB; float* SSo;
    __device__ __forceinline__ void prep(const Unit&, int, PG8_LAS unsigned char*, int) const {}
    __device__ __forceinline__ void operator()(const f32x4 (&acc)[2][2][4][2], const Unit& u, int wr, int wc, int fr, int fq, PG8_LAS unsigned char*, int) const {
        const int row0 = u.pm * BM + wr * 64 + fr, col0 = u.pn * BM + wc * 32 + 8 * fq;
        bf16_t* const base = HB + (size_t)row0 * 2048 + col0;
        u32x4 old[2][4][2];
#pragma unroll
        for (int ai = 0; ai < 2; ++ai)
#pragma unroll
            for (int m = 0; m < 4; ++m)
#pragma unroll
                for (int bj = 0; bj < 2; ++bj) old[ai][m][bj] = *(const u32x4*)(base + (size_t)(ai * HALF + m * 16) * 2048 + bj * HALF);
#pragma unroll
        for (int ai = 0; ai < 2; ++ai)
#pragma unroll
            for (int m = 0; m < 4; ++m) { const int row = row0 + ai * HALF + m * 16; float q = 0.f;
#pragma unroll
                for (int bj = 0; bj < 2; ++bj) { const u32x4 o = old[ai][m][bj]; const f32x4 a0 = acc[ai][bj][m][0], a1 = acc[ai][bj][m][1];
                    const float h0 = bf_lo(o.x) + a0[0], h1 = bf_hi(o.x) + a0[1], h2 = bf_lo(o.y) + a0[2], h3 = bf_hi(o.y) + a0[3], h4 = bf_lo(o.z) + a1[0], h5 = bf_hi(o.z) + a1[1], h6 = bf_lo(o.w) + a1[2], h7 = bf_hi(o.w) + a1[3];
                    u32x4 w; w.x = cvt_pk_bf16(h0, h1); w.y = cvt_pk_bf16(h2, h3); w.z = cvt_pk_bf16(h4, h5); w.w = cvt_pk_bf16(h6, h7);
                    *(u32x4*)(base + (size_t)(ai * HALF + m * 16) * 2048 + bj * HALF) = w;
                    q += (h0 * h0 + h1 * h1) + (h2 * h2 + h3 * h3) + (h4 * h4 + h5 * h5) + (h6 * h6 + h7 * h7); }
                q = sum_xor32(sum_xor16(q));
                if (fq == 0) SSo[(size_t)row * 32 + u.pn * 4 + wc] = q; }
    }
};
struct EpiPle {
    static constexpr bool PERM = true, AFTER_DRAIN = false, HAS_PREP = true;
    const bf16_t* HBi; bf16_t* HBo; const bf16_t* PP; float* SSo; const float* ss;
    __device__ __forceinline__ void prep(const Unit& u, int parity, PG8_LAS unsigned char* lds, int tid) const { rs_prep(ss, u.pm, parity, lds, tid); }
    __device__ __forceinline__ void operator()(const f32x4 (&acc)[2][2][4][2], const Unit& u, int wr, int wc, int fr, int fq, PG8_LAS unsigned char* lds, int parity) const {
        float rs[8]; rs_load(rs, lds, parity, wr, fr);
        const int row0 = u.pm * BM + wr * 64 + fr, col0 = u.pn * BM + wc * 32 + 8 * fq;
        const size_t off0 = (size_t)row0 * 2048 + col0;
#pragma unroll
        for (int ai = 0; ai < 2; ++ai) {
            u32x4 old[4][2], ppv[4][2];
#pragma unroll
            for (int m = 0; m < 4; ++m)
#pragma unroll
                for (int bj = 0; bj < 2; ++bj) { const size_t o = off0 + (size_t)(ai * HALF + m * 16) * 2048 + bj * HALF; old[m][bj] = *(const u32x4*)(HBi + o); ppv[m][bj] = *(const u32x4*)(PP + o); }
#pragma unroll
            for (int m = 0; m < 4; ++m) { const int row = row0 + ai * HALF + m * 16; const float s = rs[ai * 4 + m]; float q = 0.f;
#pragma unroll
                for (int bj = 0; bj < 2; ++bj) { const u32x4 o = old[m][bj], pw = ppv[m][bj]; const f32x4 a0 = acc[ai][bj][m][0] * s, a1 = acc[ai][bj][m][1] * s;
                    const float h0 = bf_lo(o.x) + sigmoid_f(a0[0]) * bf_lo(pw.x), h1 = bf_hi(o.x) + sigmoid_f(a0[1]) * bf_hi(pw.x), h2 = bf_lo(o.y) + sigmoid_f(a0[2]) * bf_lo(pw.y), h3 = bf_hi(o.y) + sigmoid_f(a0[3]) * bf_hi(pw.y);
                    const float h4 = bf_lo(o.z) + sigmoid_f(a1[0]) * bf_lo(pw.z), h5 = bf_hi(o.z) + sigmoid_f(a1[1]) * bf_hi(pw.z), h6 = bf_lo(o.w) + sigmoid_f(a1[2]) * bf_lo(pw.w), h7 = bf_hi(o.w) + sigmoid_f(a1[3]) * bf_hi(pw.w);
                    u32x4 w; w.x = cvt_pk_bf16(h0, h1); w.y = cvt_pk_bf16(h2, h3); w.z = cvt_pk_bf16(h4, h5); w.w = cvt_pk_bf16(h6, h7);
                    *(u32x4*)(HBo + off0 + (size_t)(ai * HALF + m * 16) * 2048 + bj * HALF) = w;
                    q += (h0 * h0 + h1 * h1) + (h2 * h2 + h3 * h3) + (h4 * h4 + h5 * h5) + (h6 * h6 + h7 * h7); }
                q = sum_xor32(sum_xor16(q));
                if (fq == 0) SSo[(size_t)row * 32 + u.pn * 4 + wc] = q; }
        }
    }
};

template <class Epi, class Sched, bool ALIGN_EPI = false, bool SP2 = false>
__device__ __forceinline__ void gemm_phase(PG8_LAS unsigned char* lds, const Gemm g, const Sched& S, const Epi& E, const int wave_id) {
    int lane_; asm volatile("v_mbcnt_lo_u32_b32 %0, -1, 0\n\tv_mbcnt_hi_u32_b32 %0, -1, %0" : "=v"(lane_));
    const int wid = wave_id, lane = (int)lane_, tid = wid * 64 + lane, wr = wid >> 2, wc = wid & 3, fr = lane & 15, fq = lane >> 4;
    const int K = g.K, nt = K / BK;
    unsigned voffA[2], voffB[2];
#pragma unroll
    for (int i = 0; i < 2; ++i) { int R, C; stage_rc(tid * 16 + i * 8192, R, C); const int Rb = Epi::PERM ? ((R & ~31) + perm32(R & 31)) : R;
        voffA[i] = (unsigned)(R * K + C) * 2u; voffB[i] = (unsigned)(Rb * K + C) * 2u; }
    const size_t kstep = (size_t)(BK * 2);
    const size_t hstep = (size_t)HALF * K * 2;
    const size_t tstep = 2 * hstep;
    const unsigned ldsw = (unsigned)wid * 1024u;
    const int aoff = lds_byte(wr * 64 + fr, fq * 8), boff = lds_byte(wc * 32 + fr, fq * 8);
#define PG8_SA(b, h) (((b) * 2 + (h)) * HTB)
#define PG8_SB(b, h) ((4 + (b) * 2 + (h)) * HTB)
#define PG8_STAGE(bufoff, gbase, voff) do { _Pragma("unroll") for (int _i = 0; _i < 2; ++_i) \
        __builtin_amdgcn_global_load_lds((const unsigned*)((const char*)(gbase) + (voff)[_i]), (PG8_LAS unsigned*)(lds + (bufoff) + ldsw + _i * 8192), 16, 0, 0); } while (0)
#define PG8_LDA(dst, b, h) do { _Pragma("unroll") for (int m = 0; m < 4; ++m) _Pragma("unroll") for (int k = 0; k < 2; ++k) dst[m][k] = *(const PG8_LAS bf16x8*)(lds + PG8_SA(b, h) + aoff + m * 2048 + k * 1024); } while (0)
#define PG8_LDB(dst, b, h) do { _Pragma("unroll") for (int n = 0; n < 2; ++n) _Pragma("unroll") for (int k = 0; k < 2; ++k) dst[n][k] = *(const PG8_LAS bf16x8*)(lds + PG8_SB(b, h) + boff + n * 2048 + k * 1024); } while (0)
#define PG8_MMA(ai, bj, At, Bt) do { __builtin_amdgcn_s_setprio(1); _Pragma("unroll") for (int m = 0; m < 4; ++m) _Pragma("unroll") for (int n = 0; n < 2; ++n) _Pragma("unroll") for (int k = 0; k < 2; ++k) \
        acc[ai][bj][m][n] = __builtin_amdgcn_mfma_f32_16x16x32_bf16(Bt[n][k], At[m][k], acc[ai][bj][m][n], 0, 0, 0); __builtin_amdgcn_s_setprio(0); } while (0)
#define PG8_WAIT_V(n) asm volatile("s_waitcnt vmcnt(" #n ")" ::: "memory")
#define PG8_WAIT_L(n) asm volatile("s_waitcnt lgkmcnt(" #n ")" ::: "memory")
#define PG8_BAR __builtin_amdgcn_s_barrier()
#define PG8_SCHED __builtin_amdgcn_sched_barrier(0)
    Unit cur, nxt; int ui = 0, tp = 0;
    if (!S.next(0, cur)) return;
    f32x4 acc[2][2][4][2];
#pragma unroll
    for (int a = 0; a < 2; ++a)
#pragma unroll
        for (int b = 0; b < 2; ++b)
#pragma unroll
            for (int m = 0; m < 4; ++m)
#pragma unroll
                for (int n = 0; n < 2; ++n) acc[a][b][m][n] = (f32x4){0.f, 0.f, 0.f, 0.f};
    bf16x8 At[4][2], B0[2][2], B1[2][2];
    const char* cA = (const char*)g.A + (size_t)cur.lm * tstep; const char* cB = (const char*)g.Bt + (size_t)cur.ln * tstep;
    if constexpr (Epi::HAS_PREP) E.prep(cur, 0, lds, tid);
    S.a_ready(cur);
    if constexpr (SP2) {
        PG8_STAGE(PG8_SB(0, 0), cB, voffB); PG8_STAGE(PG8_SB(0, 1), cB + hstep, voffB); PG8_STAGE(PG8_SA(0, 0), cA, voffA); PG8_STAGE(PG8_SA(0, 1), cA + hstep, voffA);
        if (wr == 1) PG8_BAR;
        PG8_WAIT_V(2); PG8_BAR;
        PG8_STAGE(PG8_SB(1, 0), cB + kstep, voffB); PG8_STAGE(PG8_SA(1, 0), cA + kstep, voffA); PG8_STAGE(PG8_SB(1, 1), cB + hstep + kstep, voffB);
        PG8_WAIT_V(6); PG8_BAR;
    } else {
        PG8_STAGE(PG8_SB(0, 0), cB, voffB); PG8_STAGE(PG8_SA(0, 0), cA, voffA); PG8_STAGE(PG8_SB(0, 1), cB + hstep, voffB); PG8_STAGE(PG8_SA(0, 1), cA + hstep, voffA);
        if (wr == 1) PG8_BAR;
        PG8_WAIT_V(4); PG8_BAR;
        PG8_STAGE(PG8_SB(1, 0), cB + kstep, voffB); PG8_STAGE(PG8_SA(1, 0), cA + kstep, voffA); PG8_STAGE(PG8_SB(1, 1), cB + hstep + kstep, voffB);
        PG8_WAIT_V(6); PG8_BAR;
    }
    for (;;) {
        const bool has_next = S.next(ui + 1, nxt);
        const char* nA = has_next ? (const char*)g.A + (size_t)nxt.lm * tstep : cA; const char* nB = has_next ? (const char*)g.Bt + (size_t)nxt.ln * tstep : cB;
#pragma unroll 1
        for (int t = 0; t < nt; t += 2) {
            const bool last = (t == nt - 2);
            const char* a1 = cA + (size_t)(t + 1) * kstep;
            const char* a2 = last ? nA : cA + (size_t)(t + 2) * kstep; const char* b2 = last ? nB : cB + (size_t)(t + 2) * kstep;
            const char* a3 = a2 + kstep; const char* b3 = b2 + kstep;
            if (last && has_next) S.a_ready(nxt);
            if constexpr (SP2) {
            PG8_LDB(B0, 0, 0); PG8_LDB(B1, 0, 1); PG8_SCHED; PG8_LDA(At, 0, 0); PG8_STAGE(PG8_SA(1, 1), a1 + hstep, voffA);
            PG8_WAIT_V(8); PG8_WAIT_L(0); PG8_BAR; PG8_MMA(0, 0, At, B0); PG8_MMA(0, 1, At, B1); PG8_BAR; PG8_SCHED;
            PG8_LDA(At, 0, 1); PG8_STAGE(PG8_SB(0, 0), b2, voffB); PG8_STAGE(PG8_SB(0, 1), b2 + hstep, voffB); PG8_STAGE(PG8_SA(0, 0), a2, voffA);
            PG8_WAIT_V(8); PG8_WAIT_L(0); PG8_BAR; PG8_MMA(1, 0, At, B0); PG8_MMA(1, 1, At, B1); PG8_BAR; PG8_SCHED;
            PG8_LDB(B0, 1, 0); PG8_LDB(B1, 1, 1); PG8_SCHED; PG8_LDA(At, 1, 0); PG8_STAGE(PG8_SA(0, 1), a2 + hstep, voffA);
            PG8_WAIT_V(8); PG8_WAIT_L(0); PG8_BAR; PG8_MMA(0, 0, At, B0); PG8_MMA(0, 1, At, B1); PG8_BAR; PG8_SCHED;
            PG8_LDA(At, 1, 1); PG8_STAGE(PG8_SB(1, 0), b3, voffB); PG8_STAGE(PG8_SB(1, 1), b3 + hstep, voffB); PG8_STAGE(PG8_SA(1, 0), a3, voffA);
            PG8_WAIT_V(8); PG8_WAIT_L(0); PG8_BAR; PG8_MMA(1, 0, At, B0); PG8_MMA(1, 1, At, B1); PG8_BAR; PG8_SCHED;
            } else {
            PG8_LDB(B0, 0, 0); PG8_SCHED; PG8_LDA(At, 0, 0); PG8_STAGE(PG8_SA(1, 1), a1 + hstep, voffA);
            PG8_WAIT_L(8); PG8_BAR; PG8_WAIT_L(0); PG8_MMA(0, 0, At, B0); PG8_BAR; PG8_SCHED;
            PG8_LDB(B1, 0, 1); PG8_STAGE(PG8_SB(0, 0), b2, voffB);
            PG8_BAR; PG8_WAIT_L(0); PG8_MMA(0, 1, At, B1); PG8_BAR;
            PG8_LDA(At, 0, 1); PG8_STAGE(PG8_SA(0, 0), a2, voffA);
            PG8_BAR; PG8_WAIT_L(0); PG8_MMA(1, 0, At, B0); PG8_BAR; PG8_SCHED;
            PG8_STAGE(PG8_SB(0, 1), b2 + hstep, voffB);
            PG8_WAIT_V(6); PG8_BAR; PG8_MMA(1, 1, At, B1); PG8_BAR;
            PG8_LDB(B0, 1, 0); PG8_SCHED; PG8_LDA(At, 1, 0); PG8_STAGE(PG8_SA(0, 1), a2 + hstep, voffA);
            PG8_WAIT_L(8); PG8_BAR; PG8_WAIT_L(0); PG8_MMA(0, 0, At, B0); PG8_BAR; PG8_SCHED;
            PG8_LDB(B1, 1, 1); PG8_STAGE(PG8_SB(1, 0), b3, voffB);
            PG8_BAR; PG8_WAIT_L(0); PG8_MMA(0, 1, At, B1); PG8_BAR;
            PG8_LDA(At, 1, 1); PG8_STAGE(PG8_SA(1, 0), a3, voffA);
            PG8_BAR; PG8_WAIT_L(0); PG8_MMA(1, 0, At, B0); PG8_BAR; PG8_SCHED;
            PG8_STAGE(PG8_SB(1, 1), b3 + hstep, voffB);
            PG8_WAIT_V(6); PG8_BAR; PG8_MMA(1, 1, At, B1); PG8_BAR;
            }
        }
        if constexpr (ALIGN_EPI) { if (wr == 0) PG8_BAR; }
        const bool newpanel = has_next && (nxt.pm != cur.pm);
        if constexpr (Epi::HAS_PREP) { if (newpanel) E.prep(nxt, tp ^ 1, lds, tid); }
        E(acc, cur, wr, wc, fr, fq, lds, tp); S.done(cur);
        if (!has_next) break;
        if (newpanel) tp ^= 1;
#pragma unroll
        for (int a = 0; a < 2; ++a)
#pragma unroll
            for (int b = 0; b < 2; ++b)
#pragma unroll
                for (int m = 0; m < 4; ++m)
#pragma unroll
                    for (int n = 0; n < 2; ++n) acc[a][b][m][n] = (f32x4){0.f, 0.f, 0.f, 0.f};
        cur = nxt; cA = nA; cB = nB; ++ui;
        if constexpr (ALIGN_EPI) { if (wr == 1) PG8_BAR; }
    }
    PG8_WAIT_V(0);
    if constexpr (!ALIGN_EPI) { if (wr == 0) PG8_BAR; }
    PG8_BAR;
#undef PG8_SA
#undef PG8_SB
#undef PG8_STAGE
#undef PG8_LDA
#undef PG8_LDB
#undef PG8_MMA
#undef PG8_WAIT_V
#undef PG8_WAIT_L
#undef PG8_BAR
#undef PG8_SCHED
}
}

constexpr int NWAVES = 8, NTHR = NWAVES * 64;
constexpr int BATCH = 8, SEQ = 4096, D = 2048, DEPTH = 4, M = BATCH * SEQ;
constexpr int GW = 512, INC = 4096, ZC = 3072, FF = 5632, PLE = 256, CONVK = 31;
constexpr int NPHASE = 2 + 6 * DEPTH;
constexpr float EPS = 1e-6f;

constexpr size_t MiB = 1u << 20;
constexpr size_t WS_CTL = 0, CTL_ZERO_BYTES = 32 * 1024;
constexpr size_t WS_WSB = 1 * MiB;
constexpr size_t WS_PWT = WS_WSB + 512 * 1024;
constexpr size_t WS_SS = 2 * MiB, SS_BYTES = (size_t)M * 32 * 4;
constexpr size_t WS_W = 16 * MiB, W_LAYER = 99 * MiB;
constexpr size_t WO_IN = 0, WO_OUT = 16 * MiB, WO_GU = 24 * MiB, WO_D = 68 * MiB, WO_PG = 90 * MiB, WO_PP = 98 * MiB;
constexpr size_t WS_PBF = WS_W + DEPTH * W_LAYER;
constexpr size_t WS_HB0 = WS_PBF + 64 * MiB, WS_HB1 = WS_HB0 + 128 * MiB;
constexpr size_t WS_R = WS_HB1 + 128 * MiB;
constexpr size_t WS_Z = WS_R, WS_MIX = WS_R + 256 * MiB, WS_T = WS_R, WS_PP = WS_R;
constexpr size_t WS_END = WS_R + 384 * MiB;
static_assert(WS_SS + 3 * SS_BYTES <= WS_W && (size_t)M * FF * 2 <= 384 * MiB && WS_PBF == 412 * MiB && WS_END == 1116 * MiB, "d_ws map");
constexpr int CW_BAR = 4096;
static_assert((CW_BAR + 3456) * 4 <= (int)CTL_ZERO_BYTES, "barrier words inside the memset block");

constexpr int RING_BYTES = 131072;
constexpr int LDSCTL_OFF = RING_BYTES + 2048;
constexpr int MISC_OFF = LDSCTL_OFF + 320;
constexpr int LDS_BYTES = 147456;
static_assert(MISC_OFF + 128 <= LDS_BYTES && pg8::RS_OFF == RING_BYTES, "LDS map");

#define GAS __attribute__((address_space(1)))
#define LAS __attribute__((address_space(3)))
typedef unsigned short bf16;
typedef unsigned v4u __attribute__((ext_vector_type(4)));
typedef unsigned v2u __attribute__((ext_vector_type(2)));
typedef float f32x4 __attribute__((ext_vector_type(4)));
typedef float f32x2 __attribute__((ext_vector_type(2)));
typedef short bf16x8 __attribute__((ext_vector_type(8)));
typedef GAS unsigned gu32;
#define RLX_AGENT __ATOMIC_RELAXED, __HIP_MEMORY_SCOPE_AGENT
using pg8::cvt_pk_bf16; using pg8::sigmoid_f; using pg8::silu_f; using pg8::gelu_f; using pg8::bf_lo; using pg8::bf_hi;

#define XB_TMO      128
#define XB_XCNT(j)  (256  + 64 * (j))
#define XB_XSUB(j)  (1280 + 64 * (j))
#define XB_XGEN(j)  (2304 + 64 * (j))
#define XB_TOP      3328
#define XB_TOPGEN   3392
#define XCD_BAR_WORDS 3456
#define XB_SPIN_CAP (1u << 18)

__device__ __forceinline__ unsigned xb_ld(unsigned* p)              { return __hip_atomic_load(p, __ATOMIC_RELAXED, __HIP_MEMORY_SCOPE_AGENT); }
__device__ __forceinline__ unsigned xb_add(unsigned* p, unsigned v) { return __hip_atomic_fetch_add(p, v, __ATOMIC_RELAXED, __HIP_MEMORY_SCOPE_AGENT); }
__device__ __forceinline__ unsigned xb_xcc_id() { return (unsigned)__builtin_amdgcn_s_getreg((3 << 11) | 20) & 0xFu; }
#define XB_SPIN(cond, bar) do { unsigned _sp = 0; while (cond) { __builtin_amdgcn_s_sleep(1); \
    if ((++_sp & 255u) == 0u) { if (xb_ld(&(bar)[XB_TMO])) break; if (_sp > XB_SPIN_CAP) { atomicAdd(&(bar)[XB_TMO], 1u); break; } } } } while (0)

__device__ __forceinline__ int lane_id() { return (int)__builtin_amdgcn_mbcnt_hi(~0u, __builtin_amdgcn_mbcnt_lo(~0u, 0u)); }
struct XcdBarrier {
    unsigned* bar; unsigned x;
    volatile LAS unsigned* st;
    int wave;
};
__device__ __forceinline__ int lane_opaque() { int l; asm volatile("v_mbcnt_lo_u32_b32 %0, -1, 0\n\tv_mbcnt_hi_u32_b32 %0, -1, %0" : "=v"(l)); return l; }
#define XB_THREAD0(w) ((w) == 0 && lane_opaque() == 0)
__device__ __forceinline__ XcdBarrier xcd_barrier_post(unsigned* bar, volatile LAS unsigned* st, int wave) {
    XcdBarrier b; b.bar = bar; b.x = xb_xcc_id(); b.st = st; b.wave = wave;
    if (XB_THREAD0(wave)) (void)xb_add(&bar[XB_XCNT(b.x)], 1u);
    return b;
}
__device__ __forceinline__ void xcd_barrier_complete(unsigned* bar, unsigned x, unsigned& nloc, unsigned& nx) {
    const unsigned G = gridDim.x * gridDim.y * gridDim.z;
    unsigned sum, cnt, mine, sp = 0u;
    for (;;) {
        sum = 0u; cnt = 0u; mine = 0u;
#pragma unroll
        for (unsigned j = 0; j < 16; ++j) { const unsigned c = xb_ld(&bar[XB_XCNT(j)]); sum += c; cnt += (c > 0u) ? 1u : 0u; mine = (j == x) ? c : mine; }
        if (sum == G) break;
        __builtin_amdgcn_s_sleep(1);
        if ((++sp & 255u) == 0u) { if (xb_ld(&bar[XB_TMO])) break; if (sp > XB_SPIN_CAP) { atomicAdd(&bar[XB_TMO], 1u); break; } }
    }
    nloc = mine > 0u ? mine : 1u; nx = cnt > 0u ? cnt : 1u;
}
__device__ __forceinline__ void xcd_barrier(const XcdBarrier& b) {
    asm volatile("s_waitcnt vmcnt(0)" ::: "memory");
    __syncthreads();
    if (XB_THREAD0(b.wave)) {
        unsigned* bar = b.bar;
        __builtin_amdgcn_s_waitcnt(0);
        unsigned nloc = b.st[0], nx = b.st[1];
        if (nloc == 0u) { xcd_barrier_complete(bar, b.x, nloc, nx); b.st[0] = nloc; b.st[1] = nx; }
        const unsigned old = xb_add(&bar[XB_XSUB(b.x)], 1u);
        const unsigned gen = old / nloc;
        if (old + 1u == (gen + 1u) * nloc) {
            __builtin_amdgcn_fence(__ATOMIC_RELEASE, "agent");
            asm volatile("s_waitcnt vmcnt(0)" ::: "memory");
            const unsigned og = xb_add(&bar[XB_TOP], 1u);
            const unsigned tg = og / nx;
            if (og + 1u == (tg + 1u) * nx) xb_add(&bar[XB_TOPGEN], 1u);
            else XB_SPIN(xb_ld(&bar[XB_TOPGEN]) == tg, bar);
            __builtin_amdgcn_fence(__ATOMIC_ACQUIRE, "agent");
            xb_add(&bar[XB_XGEN(b.x)], 1u);
            asm volatile("s_waitcnt vmcnt(0)" ::: "memory");
        } else {
            XB_SPIN(xb_ld(&bar[XB_XGEN(b.x)]) == gen, bar);
            __builtin_amdgcn_fence(__ATOMIC_ACQUIRE, "agent");
            asm volatile("s_waitcnt vmcnt(0)" ::: "memory");
        }
    }
    __syncthreads();
}

struct Args {
    const float* in[24]; float* out; unsigned char* ws; int ph_lo, ph_hi;
};
struct Frame {
    LAS unsigned char* lds;
    int wave, G, gw, NGW;
    GAS float* out; GAS unsigned char* ws;
};
__device__ __forceinline__ Frame phase_frame(const Frame& F) { Frame P = F; asm volatile("" : "+s"(P.wave), "+s"(P.gw), "+s"(P.ws), "+s"(P.out)); return P; }
__device__ __forceinline__ float wave_sum(float v) { return pg8::wave_sum_f(v); }
__device__ __forceinline__ void unpack8(const v4u w, float (&f)[8]) { f[0] = bf_lo(w.x); f[1] = bf_hi(w.x); f[2] = bf_lo(w.y); f[3] = bf_hi(w.y); f[4] = bf_lo(w.z); f[5] = bf_hi(w.z); f[6] = bf_lo(w.w); f[7] = bf_hi(w.w); }
__device__ __forceinline__ v4u pack8(const float (&f)[8]) { v4u w; w.x = cvt_pk_bf16(f[0], f[1]); w.y = cvt_pk_bf16(f[2], f[3]); w.z = cvt_pk_bf16(f[4], f[5]); w.w = cvt_pk_bf16(f[6], f[7]); return w; }
__device__ __forceinline__ bf16 f2bf(float f) { return (bf16)(cvt_pk_bf16(f, 0.f) & 0xffffu); }

struct TItem { const float* W; const float* gain; bf16* WT; int ldw, K, k0, n0, drow0; };
__device__ __forceinline__ void p0_item_load(const TItem& t, float (&wv)[32], float& gk, int lane) {
#pragma unroll
    for (int i = 0; i < 32; ++i) wv[i] = t.W[(size_t)(t.k0 + 2 * i + (lane >> 5)) * t.ldw + t.n0 + (lane & 31)];
    gk = t.gain ? t.gain[t.k0 + lane] : 1.0f;
}
__device__ __forceinline__ void p0_item_finish(const TItem& t, const float (&wv)[32], float gk, LAS float* scr, int lane) {
#pragma unroll
    for (int i = 0; i < 32; ++i) { const int kk = 2 * i + (lane >> 5); scr[kk * 33 + (lane & 31)] = wv[i] * __shfl(gk, kk); }
    asm volatile("s_waitcnt lgkmcnt(0)" ::: "memory");
    const int c = lane & 7;
#pragma unroll
    for (int j = 0; j < 4; ++j) { const int n = (lane >> 3) + 8 * j; const LAS float* sp = scr + (8 * c) * 33 + n;
        v4u o; o.x = cvt_pk_bf16(sp[0 * 33], sp[1 * 33]); o.y = cvt_pk_bf16(sp[2 * 33], sp[3 * 33]); o.z = cvt_pk_bf16(sp[4 * 33], sp[5 * 33]); o.w = cvt_pk_bf16(sp[6 * 33], sp[7 * 33]);
        *(GAS v4u*)(t.WT + (size_t)(t.drow0 + n) * t.K + t.k0 + 8 * c) = o; }
    asm volatile("s_waitcnt lgkmcnt(0)" ::: "memory");
}
constexpr int I_IN = (D / 64) * (INC / 32), I_OUT = (D / 64) * (D / 32), I_GU = (D / 64) * (2 * FF / 32), I_D = (FF / 64) * (D / 32), I_PG = I_OUT, I_PP = (PLE / 64) * (D / 32);
constexpr int I_LAYER = I_IN + I_OUT + I_GU + I_D + I_PG + I_PP;
__device__ __forceinline__ TItem p0_item(const Frame& F, const Args& A, int it) {
    const int l = DEPTH - 1 - it / I_LAYER; int r = I_LAYER - 1 - it % I_LAYER;
    unsigned char* wl = (unsigned char*)(F.ws + WS_W + (size_t)l * W_LAYER);
    if (r < I_IN) { const int nb = INC / 32, kb = r / nb, rg = r % nb, pn = rg >> 3, j = rg & 7;
        const int src = pn < 4 ? 256 * pn + 32 * j : pn < 8 ? (j < 4 ? 1024 : 2048) + 128 * (pn - 4) + 32 * (j & 3) : pn < 10 ? 1536 + 256 * (pn - 8) + 32 * j
                      : pn < 14 ? (j < 4 ? 2560 : 3072) + 128 * (pn - 10) + 32 * (j & 3) : 3584 + 256 * (pn - 14) + 32 * j;
        return TItem{A.in[3] + (size_t)l * D * INC, A.in[2] + l * D, (bf16*)(wl + WO_IN), INC, D, 64 * kb, src, 32 * rg}; } r -= I_IN;
    if (r < I_OUT) { const int nb = D / 32, kb = r / nb, rg = r % nb;
        return TItem{A.in[15] + (size_t)l * D * D, nullptr, (bf16*)(wl + WO_OUT), D, D, 64 * kb, 32 * rg, 32 * rg}; } r -= I_OUT;
    if (r < I_GU) { const int nb = 2 * FF / 32, kb = r / nb, rg = r % nb, pn = rg >> 3, j = rg & 7;
        return TItem{(j < 4 ? A.in[17] : A.in[18]) + (size_t)l * D * FF, A.in[16] + l * D, (bf16*)(wl + WO_GU), FF, D, 64 * kb, 128 * pn + 32 * (j & 3), 32 * rg}; } r -= I_GU;
    if (r < I_D) { const int nb = D / 32, kb = r / nb, rg = r % nb;
        return TItem{A.in[19] + (size_t)l * FF * D, nullptr, (bf16*)(wl + WO_D), D, FF, 64 * kb, 32 * rg, 32 * rg}; } r -= I_D;
    if (r < I_PG) { const int nb = D / 32, kb = r / nb, rg = r % nb;
        return TItem{A.in[21] + (size_t)l * D * D, A.in[20] + l * D, (bf16*)(wl + WO_PG), D, D, 64 * kb, 32 * rg, 32 * rg}; } r -= I_PG;
    { const int nb = D / 32, kb = r / nb, rg = r % nb;
        return TItem{A.in[22] + (size_t)l * PLE * D, nullptr, (bf16*)(wl + WO_PP), D, PLE, 64 * kb, 32 * rg, 32 * rg}; }
}
__device__ __forceinline__ void p0_prologue(const Frame& F, const Args& A) {
    const int lane = lane_opaque();
    LAS float* scr = (LAS float*)(F.lds + F.wave * 16384);
    { constexpr int NIT = DEPTH * I_LAYER;
      int it = F.gw;
      if (it < NIT) {
        TItem cur = p0_item(F, A, it); float wa[32], ga; p0_item_load(cur, wa, ga, lane);
        for (;;) {
            const int nx = it + F.NGW; const bool has = nx < NIT;
            TItem nxt = cur; float wb[32], gb = 0.f;
#pragma unroll
            for (int i = 0; i < 32; ++i) wb[i] = 0.f;
            if (has) { nxt = p0_item(F, A, nx); p0_item_load(nxt, wb, gb, lane); }
            p0_item_finish(cur, wa, ga, scr, lane);
            if (!has) break;
            cur = nxt; ga = gb; it = nx;
#pragma unroll
            for (int i = 0; i < 32; ++i) wa[i] = wb[i];
        } } }
    { const float* x = A.in[0]; bf16* hb = (bf16*)(F.ws + WS_HB0); float* ss = (float*)(F.ws + WS_SS);
        for (int m = F.gw; m < M; m += F.NGW) {
            const GAS f32x4* xr = (const GAS f32x4*)(x + (size_t)m * D) + lane;
            GAS v2u* hrow = (GAS v2u*)(hb + (size_t)m * D) + lane;
            f32x4 v[8]; float q = 0.f;
#pragma unroll
            for (int j = 0; j < 8; ++j) v[j] = xr[64 * j];
#pragma unroll
            for (int j = 0; j < 8; ++j) { v2u w; w.x = cvt_pk_bf16(v[j][0], v[j][1]); w.y = cvt_pk_bf16(v[j][2], v[j][3]); hrow[64 * j] = w;
                q += (v[j][0] * v[j][0] + v[j][1] * v[j][1]) + (v[j][2] * v[j][2] + v[j][3] * v[j][3]); }
            q = wave_sum(q);
            if (lane < 32) ss[(size_t)m * 32 + lane] = (lane == 0) ? q : 0.f;
        } }
    { const GAS f32x4* p = (const GAS f32x4*)A.in[1]; GAS v4u* o = (GAS v4u*)(F.ws + WS_PBF); const size_t n8 = (size_t)DEPTH * M * PLE / 8;
        const size_t st = (size_t)F.NGW * 64;
        for (size_t i = (size_t)F.gw * 64 + lane; i < n8; i += 4 * st) { f32x4 a[4], b[4];
#pragma unroll
            for (int j = 0; j < 4; ++j) if (i + j * st < n8) { a[j] = p[2 * (i + j * st)]; b[j] = p[2 * (i + j * st) + 1]; }
#pragma unroll
            for (int j = 0; j < 4; ++j) if (i + j * st < n8) { v4u w; w.x = cvt_pk_bf16(a[j][0], a[j][1]); w.y = cvt_pk_bf16(a[j][2], a[j][3]); w.z = cvt_pk_bf16(b[j][0], b[j][1]); w.w = cvt_pk_bf16(b[j][2], b[j][3]); o[i + j * st] = w; } } }
    { bf16* wsb = (bf16*)(F.ws + WS_WSB); bf16* pwt = (bf16*)(F.ws + WS_PWT); const int n = DEPTH * 4 * 128 * 128;
        for (int i = F.gw * 64 + lane; i < n; i += F.NGW * 64) {
            const int s = i & 127, t = (i >> 7) & 127;
            wsb[i] = f2bf((s <= t) ? A.in[6][i] : 0.f);
            const int c = i & 127, d = (i >> 7) & 127, lg = i >> 14;
            pwt[i] = f2bf(A.in[13][((size_t)lg * 128 + c) * 128 + d] * A.in[14][lg * 128 + d]);
        } }
}

__device__ __forceinline__ void mixer_shortconv(const Frame& F, const Args& A, int l, int chunk, const bf16* Z, bf16* MIX) {
    const int lane = lane_opaque();
    const int c8 = lane * 8, row0 = chunk * 128, pos0 = (chunk & 31) * 128, t0 = F.wave * 16;
    const float* cw = A.in[8] + (size_t)l * 3 * GW;
    float w0[8], w1[8], w2[8];
#pragma unroll
    for (int j = 0; j < 8; ++j) { w0[j] = cw[c8 + j]; w1[j] = cw[GW + c8 + j]; w2[j] = cw[2 * GW + c8 + j]; }
    float xm2[8], xm1[8];
#pragma unroll
    for (int j = 0; j < 8; ++j) { xm2[j] = 0.f; xm1[j] = 0.f; }
#pragma unroll
    for (int dt = -2; dt < 16; ++dt) {
        const int t = t0 + dt; const bool valid = (pos0 + t) >= 0;
        const bf16* zr = Z + (size_t)(row0 + (valid ? t : 0)) * ZC;
        float xv[8], x[8];
        unpack8(*(const GAS v4u*)(zr + 1024 + c8), xv);
#pragma unroll
        for (int j = 0; j < 8; ++j) x[j] = valid ? xv[j] : 0.f;
        if (dt >= 0) { float bg[8], o[8]; unpack8(*(const GAS v4u*)(zr + 1536 + c8), bg);
#pragma unroll
            for (int j = 0; j < 8; ++j) o[j] = bg[j] * (w0[j] * xm2[j] + w1[j] * xm1[j] + w2[j] * x[j]);
            *(GAS v4u*)(MIX + (size_t)(row0 + t) * D + 512 + c8) = pack8(o); }
#pragma unroll
        for (int j = 0; j < 8; ++j) { xm2[j] = xm1[j]; xm1[j] = x[j]; }
    }
}
template <int SH> __device__ __forceinline__ float row_shr(float v) { return __int_as_float(__builtin_amdgcn_update_dpp(0, __float_as_int(v), 0x110 + SH, 0xf, 0xf, true)); }
template <int SH> __device__ __forceinline__ float row_shl(float v) { return __int_as_float(__builtin_amdgcn_update_dpp(0, __float_as_int(v), 0x100 + SH, 0xf, 0xf, true)); }
template <int S> __device__ __forceinline__ void win_step(float (&c)[8], float (&p)[8]) {
#pragma unroll
    for (int j = 0; j < 8; ++j) { const float cn = c[j] + row_shr<S>(c[j]) + row_shl<16 - S>(p[j]); p[j] += row_shr<S>(p[j]); c[j] = cn; }
}
template <int W> __device__ __forceinline__ void pool_group(const bf16* zrow  , const bf16* pw  , bf16* orow  , int pos, bool prev_ok) {
    const float inv = 1.0f / (float)((pos + 1) < W ? (pos + 1) : W);
    f32x4 acc[8];
#pragma unroll
    for (int dt = 0; dt < 8; ++dt) acc[dt] = (f32x4){0.f, 0.f, 0.f, 0.f};
    v4u cw[4], pv[4], aw[2][8];
#pragma unroll
    for (int kk = 0; kk < 4; ++kk) { cw[kk] = *(const GAS v4u*)(zrow + 32 * kk); pv[kk] = prev_ok ? *(const GAS v4u*)(zrow + 32 * kk - (ptrdiff_t)16 * ZC) : (v4u){0u, 0u, 0u, 0u}; }
#pragma unroll
    for (int dt = 0; dt < 8; ++dt) aw[0][dt] = *(const GAS v4u*)(pw + (size_t)16 * dt * 128);
#pragma unroll
    for (int kk = 0; kk < 4; ++kk) {
        if (kk < 3) {
#pragma unroll
            for (int dt = 0; dt < 8; ++dt) aw[(kk + 1) & 1][dt] = *(const GAS v4u*)(pw + (size_t)16 * dt * 128 + 32 * (kk + 1)); }
        float own[8], c[8], p[8];
        unpack8(cw[kk], own); unpack8(pv[kk], p);
#pragma unroll
        for (int j = 0; j < 8; ++j) c[j] = own[j];
        win_step<1>(c, p);
        if (W >= 4) win_step<2>(c, p);
        if (W >= 8) win_step<4>(c, p);
        if (W >= 16) win_step<8>(c, p);
        float pl[8];
#pragma unroll
        for (int j = 0; j < 8; ++j) pl[j] = c[j] * inv - own[j];
        const v4u pwk = pack8(pl); const bf16x8 pf = __builtin_bit_cast(bf16x8, pwk);
#pragma unroll
        for (int dt = 0; dt < 8; ++dt) acc[dt] = __builtin_amdgcn_mfma_f32_16x16x32_bf16(__builtin_bit_cast(bf16x8, aw[kk & 1][dt]), pf, acc[dt], 0, 0, 0);
    }
#pragma unroll
    for (int dt = 0; dt < 8; ++dt) { v2u w; w.x = cvt_pk_bf16(acc[dt][0], acc[dt][1]); w.y = cvt_pk_bf16(acc[dt][2], acc[dt][3]); *(GAS v2u*)(orow + 16 * dt) = w; }
}
__device__ __forceinline__ void mixer_pool(const Frame& F, int l, int chunk, const bf16* Z, bf16* MIX) {
    const int lane = lane_opaque();
    const int i = lane & 15, g4 = lane >> 4, t = F.wave * 16 + i, row = chunk * 128 + t, pos = (chunk & 31) * 128 + t;
    const bool prev_ok = ((chunk & 31) * 128 + F.wave * 16) > 0;
    const bf16* pwt = (const bf16*)(F.ws + WS_PWT) + (size_t)l * 4 * 128 * 128 + (size_t)i * 128 + 8 * g4;
    const bf16* zrow = Z + (size_t)row * ZC + 2560 + 8 * g4; bf16* orow = MIX + (size_t)row * D + 1536 + 4 * g4;
    pool_group<2>(zrow, pwt, orow, pos, prev_ok);
    pool_group<4>(zrow + 128, pwt + 128 * 128, orow + 128, pos, prev_ok);
    pool_group<8>(zrow + 256, pwt + 2 * 128 * 128, orow + 256, pos, prev_ok);
    pool_group<16>(zrow + 384, pwt + 3 * 128 * 128, orow + 384, pos, prev_ok);
}
constexpr int VT_STRIDE = 136;
__device__ __forceinline__ void mixer_sgu(const Frame& F, const Args& A, int l, int chunk, const bf16* Z, bf16* MIX) {
    const int lane = lane_opaque(), tid = F.wave * 64 + lane;
    const int row0 = chunk * 128;
    const bf16* wsb = (const bf16*)(F.ws + WS_WSB) + (size_t)l * 4 * 128 * 128;
    const int t1 = tid >> 2, q = tid & 3, i = lane & 15, g4 = lane >> 4, w = F.wave, t2 = 16 * w + i, kkmax = w >> 1;
    const bf16* zv = Z + (size_t)(row0 + t1) * ZC + 512 + 32 * q;
    const bf16* zu = Z + (size_t)(row0 + t2) * ZC + 4 * g4;
    bf16* mo = MIX + (size_t)(row0 + t2) * D + 4 * g4;
    v4u vr[4];
#pragma unroll
    for (int j = 0; j < 4; ++j) vr[j] = *(const GAS v4u*)(zv + 8 * j);
#pragma unroll 1
    for (int hd = 0; hd < 4; ++hd) {
        LAS bf16* VT = (LAS bf16*)(F.lds + (hd & 1) * (128 * VT_STRIDE * 2));
        {
            const float* lg = A.in[4] + (size_t)(l * 4 + hd) * 128 + 32 * q; const float* lb = A.in[5] + (size_t)(l * 4 + hd) * 128 + 32 * q;
            f32x4 g4v[8], b4v[8];
#pragma unroll
            for (int j = 0; j < 8; ++j) { g4v[j] = *(const GAS f32x4*)(lg + 4 * j); b4v[j] = *(const GAS f32x4*)(lb + 4 * j); }
            float v[32];
#pragma unroll
            for (int j = 0; j < 4; ++j) { float f[8]; unpack8(vr[j], f);
#pragma unroll
                for (int e = 0; e < 8; ++e) v[8 * j + e] = f[e]; }
            float s = 0.f;
#pragma unroll
            for (int j = 0; j < 32; ++j) s += v[j];
            s = pg8::sum_xor1_2(s);
            const float mean = s * (1.0f / 128.0f); float s2 = 0.f;
#pragma unroll
            for (int j = 0; j < 32; ++j) { v[j] -= mean; s2 += v[j] * v[j]; }
            s2 = pg8::sum_xor1_2(s2);
            const float rstd = __builtin_amdgcn_rsqf(s2 * (1.0f / 128.0f) + EPS);
#pragma unroll
            for (int j = 0; j < 32; ++j) { const float y = v[j] * rstd * g4v[j >> 2][j & 3] + b4v[j >> 2][j & 3]; VT[(32 * q + j) * VT_STRIDE + t1] = f2bf(y); }
        }
        if (hd < 3) {
#pragma unroll
            for (int j = 0; j < 4; ++j) vr[j] = *(const GAS v4u*)(zv + 128 * (hd + 1) + 8 * j); }
        bf16x8 bfrag[4];
#pragma unroll
        for (int kk = 0; kk < 4; ++kk) { v4u bw = (v4u){0u, 0u, 0u, 0u}; if (kk <= kkmax) bw = *(const GAS v4u*)(wsb + ((size_t)hd * 128 + t2) * 128 + 32 * kk + 8 * g4); bfrag[kk] = __builtin_bit_cast(bf16x8, bw); }
        const float bs = A.in[7][(size_t)(l * 4 + hd) * 128 + t2];
        v2u uw[8];
#pragma unroll
        for (int dt = 0; dt < 8; ++dt) uw[dt] = *(const GAS v2u*)(zu + 128 * hd + 16 * dt);
        __syncthreads();
#pragma unroll
        for (int dt = 0; dt < 8; ++dt) {
            f32x4 acc = (f32x4){0.f, 0.f, 0.f, 0.f};
#pragma unroll
            for (int kk = 0; kk < 4; ++kk) if (kk <= kkmax) { const bf16x8 af = *(const LAS bf16x8*)(VT + (16 * dt + i) * VT_STRIDE + 32 * kk + 8 * g4);
                acc = __builtin_amdgcn_mfma_f32_16x16x32_bf16(af, bfrag[kk], acc, 0, 0, 0); }
            v2u o; o.x = cvt_pk_bf16(bf_lo(uw[dt].x) * (acc[0] + bs), bf_hi(uw[dt].x) * (acc[1] + bs)); o.y = cvt_pk_bf16(bf_lo(uw[dt].y) * (acc[2] + bs), bf_hi(uw[dt].y) * (acc[3] + bs));
            *(GAS v2u*)(mo + 128 * hd + 16 * dt) = o;
        }
    }
    __syncthreads();
}
__device__ __forceinline__ f32x2 glu_pair(const bf16* zr) {
    const unsigned hw = *(const GAS unsigned*)(zr + 2048);
    f32x2 hh; hh.x = bf_lo(hw); hh.y = bf_hi(hw); return hh;
}
__device__ __forceinline__ void mixer_conformer(const Frame& F, const Args& A, int l, int chunk, const bf16* Z, bf16* MIX) {
    const int lane = lane_opaque(), tid = F.wave * 64 + lane;
    const int row0 = chunk * 128, pos0 = (chunk & 31) * 128;
    LAS unsigned char* ybuf = F.lds;
    {
        const int cp = tid & 255, s2 = F.wave >> 2, c0 = 2 * cp;
        const float* cw = A.in[9] + (size_t)l * CONVK * GW + c0;
        f32x2 wk[CONVK];
#pragma unroll
        for (int k = 0; k < CONVK; ++k) wk[k] = *(const GAS f32x2*)(cw + (size_t)k * GW);
        const f32x2 bias = *(const GAS f32x2*)(A.in[10] + (size_t)l * GW + c0);
        f32x2 win[32];
        const bf16* zp = Z + (size_t)(row0 + 64 * s2) * ZC + c0;
        if (pos0 + 64 * s2 > 0) {
#pragma unroll
            for (int r = 0; r < 32; ++r) win[r] = glu_pair(zp - (ptrdiff_t)(32 - r) * ZC);
        } else {
#pragma unroll
            for (int r = 0; r < 32; ++r) win[r] = (f32x2){0.f, 0.f};
        }
#pragma unroll 1
        for (int rd = 0; rd < 2; ++rd) {
            unsigned raw[32];
#pragma unroll
            for (int r = 0; r < 32; ++r) raw[r] = *(const GAS unsigned*)(zp + (size_t)r * ZC + 2048);
#pragma unroll
            for (int r = 0; r < 32; ++r) {
                win[r] = (f32x2){bf_lo(raw[r]), bf_hi(raw[r])};
                f32x2 y = bias;
#pragma unroll
                for (int k = 0; k < CONVK; ++k) y += wk[k] * win[(r + 2 + k) & 31];
                *(LAS unsigned*)(ybuf + (size_t)(64 * s2 + 32 * rd + r) * 1024 + cp * 4) = cvt_pk_bf16(y.x, y.y);
            }
            zp += (size_t)32 * ZC;
        }
    }
    __syncthreads();
    {
        const int c8 = lane * 8;
        float lg[8], lb[8];
#pragma unroll
        for (int j = 0; j < 8; ++j) { lg[j] = A.in[11][(size_t)l * GW + c8 + j]; lb[j] = A.in[12][(size_t)l * GW + c8 + j]; }
#pragma unroll 2
        for (int tt = 0; tt < 16; ++tt) {
            const int t = F.wave * 16 + tt;
            float v[8]; unpack8(*(const LAS v4u*)(ybuf + (size_t)t * 1024 + lane * 16), v);
            float s = 0.f;
#pragma unroll
            for (int j = 0; j < 8; ++j) s += v[j];
            const float mean = wave_sum(s) * (1.0f / 512.0f); float q = 0.f;
#pragma unroll
            for (int j = 0; j < 8; ++j) { v[j] -= mean; q += v[j] * v[j]; }
            const float rstd = __builtin_amdgcn_rsqf(wave_sum(q) * (1.0f / 512.0f) + EPS);
            float o[8];
#pragma unroll
            for (int j = 0; j < 8; ++j) o[j] = silu_f(v[j] * rstd * lg[j] + lb[j]);
            *(GAS v4u*)(MIX + (size_t)(row0 + t) * D + 1024 + c8) = pack8(o);
        }
    }
    __syncthreads();
}

__global__ void __launch_bounds__(NTHR, 2) trunk_fwd(Args args) {
    extern __shared__ __attribute__((aligned(16))) unsigned char lds[];
    Frame F;
    F.lds = (LAS unsigned char*)lds;
    F.wave = __builtin_amdgcn_readfirstlane(threadIdx.x >> 6);
    F.G = gridDim.x; F.gw = blockIdx.x * NWAVES + F.wave; F.NGW = F.G * NWAVES;
    F.out = (GAS float*)args.out; F.ws = (GAS unsigned char*)args.ws;
    volatile LAS unsigned* MISC = (volatile LAS unsigned*)(F.lds + MISC_OFF);
    { const int tid0 = F.wave * 64 + lane_opaque();
      for (int u = tid0; u < (LDS_BYTES - LDSCTL_OFF) / 4; u += NTHR) ((LAS unsigned*)(F.lds + LDSCTL_OFF))[u] = 0u; }
    __syncthreads();
    unsigned* barw = (unsigned*)((unsigned char*)args.ws + WS_CTL) + CW_BAR;
    XcdBarrier bar; bar.bar = barw; bar.x = 0; bar.st = nullptr; bar.wave = F.wave;
    const int lo = args.ph_lo, hi = args.ph_hi;
    if (hi - lo > 1) bar = xcd_barrier_post(barw, MISC + 8, F.wave);
#define IN(k) (lo <= (k) && (k) < hi)
#define SEAM(k) do { if (IN(k) && IN((k) + 1)) xcd_barrier(bar); } while (0)

    if (IN(0)) { const Frame P = phase_frame(F); for (int rep = 0; rep < ((PROBE_DUP >> 6) & 1) + 1; ++rep) p0_prologue(P, args); }
    SEAM(0);

#define PHASE_PTRS const Frame P = phase_frame(F); const int bid = P.gw >> 3; \
    const unsigned char* const wl = (const unsigned char*)(P.ws + WS_W + (size_t)l * W_LAYER); bf16* const HBc = (bf16*)(P.ws + ((l & 1) ? WS_HB1 : WS_HB0)); bf16* const HBn = (bf16*)(P.ws + ((l & 1) ? WS_HB0 : WS_HB1)); \
    bf16* const Z = (bf16*)(P.ws + WS_Z); bf16* const MIX = (bf16*)(P.ws + WS_MIX); bf16* const T = (bf16*)(P.ws + WS_T); bf16* const PP = (bf16*)P.out;     \
    float* const SS0 = (float*)(P.ws + WS_SS); float* const SS1 = (float*)(P.ws + WS_SS + SS_BYTES); float* const SS2 = (float*)(P.ws + WS_SS + 2 * SS_BYTES); \
    (void)bid; (void)wl; (void)HBc; (void)HBn; (void)Z; (void)MIX; (void)T; (void)PP; (void)SS0; (void)SS1; (void)SS2;

#pragma unroll 1
    for (int l = 0; l < DEPTH; ++l) {
        const int pb = 1 + 6 * l;
        if (IN(pb + 0)) { PHASE_PTRS
            pg8::Gemm g{HBc, (const bf16*)(wl + WO_IN), M, INC, D}; pg8::StaticOrder S; S.init(M, INC, P.G, bid, 4);
            pg8::EpiG1 E{Z, SS0};
            for (int rep = 0; rep < ((PROBE_DUP >> 0) & 1) + 1; ++rep)
            pg8::gemm_phase<pg8::EpiG1, pg8::StaticOrder, true, true>(P.lds, g, S, E, P.wave);
        }
        SEAM(pb + 0);
        if (IN(pb + 1)) { PHASE_PTRS
            for (int chunk_ = bid; chunk_ < (M / 128) * (((PROBE_DUP >> 1) & 1) + 1); chunk_ += P.G) { const int cq = chunk_ & (M / 128 - 1), chunk = (P.G == 256) ? ((cq & 7) * 32 + (cq >> 3)) : cq;
                mixer_shortconv(P, args, l, chunk, Z, MIX);
                if ((PROBE_DUP >> 8) & 1) mixer_shortconv(P, args, l, chunk, Z, MIX);
                mixer_pool(P, l, chunk, Z, MIX);
                if ((PROBE_DUP >> 9) & 1) mixer_pool(P, l, chunk, Z, MIX);
                mixer_sgu(P, args, l, chunk, Z, MIX);
                if ((PROBE_DUP >> 10) & 1) mixer_sgu(P, args, l, chunk, Z, MIX);
                mixer_conformer(P, args, l, chunk, Z, MIX);
                if ((PROBE_DUP >> 11) & 1) mixer_conformer(P, args, l, chunk, Z, MIX);
            }
        }
        SEAM(pb + 1);
        if (IN(pb + 2)) { PHASE_PTRS
            pg8::Gemm g{MIX, (const bf16*)(wl + WO_OUT), M, D, D}; pg8::StaticOrder S; S.init(M, D, P.G, bid, 4);
            pg8::EpiRes E{HBc, SS1};
            pg8::gemm_phase<pg8::EpiRes, pg8::StaticOrder, true, true>(P.lds, g, S, E, P.wave);
            if ((PROBE_DUP >> 2) & 1) { pg8::EpiRes E2{HBn, SS2}; pg8::gemm_phase<pg8::EpiRes, pg8::StaticOrder, true, true>(P.lds, g, S, E2, P.wave); }
        }
        SEAM(pb + 2);
        if (IN(pb + 3)) { PHASE_PTRS
            pg8::Gemm g{HBc, (const bf16*)(wl + WO_GU), M, 2 * FF, D}; pg8::StaticOrder S; S.init(M, 2 * FF, P.G, bid);
            pg8::EpiSwiGLU E{T, FF, SS1};
            for (int rep = 0; rep < (((PROBE_DUP >> 3) | (PROBE_DUP >> 7)) & 1) + 1; ++rep) {
            if ((PROBE_DUP >> 7) & 1) S.fixed = (rep == 0);
            pg8::gemm_phase<pg8::EpiSwiGLU, pg8::StaticOrder, true, true>(P.lds, g, S, E, P.wave); }
        }
        SEAM(pb + 3);
        if (IN(pb + 4)) { PHASE_PTRS
            pg8::Gemm g{T, (const bf16*)(wl + WO_D), M, D, FF}; pg8::StaticOrder S; S.init(M, D, P.G, bid, 4); S.rev = 1;
            pg8::EpiRes E{HBc, SS2};
            pg8::gemm_phase<pg8::EpiRes, pg8::StaticOrder, true, true>(P.lds, g, S, E, P.wave);
            if ((PROBE_DUP >> 4) & 1) { pg8::EpiRes E2{HBn, SS0}; pg8::gemm_phase<pg8::EpiRes, pg8::StaticOrder, true, true>(P.lds, g, S, E2, P.wave); }
        }
        if (IN(pb + 4)) { PHASE_PTRS
            { pg8::Gemm g{(const bf16*)(P.ws + WS_PBF) + (size_t)l * M * PLE, (const bf16*)(wl + WO_PP), M, D, PLE}; pg8::StaticOrder S; S.init(M, D, P.G, bid, 4);
              pg8::EpiStore<false> E{PP, D, nullptr};
              pg8::gemm_phase<pg8::EpiStore<false>, pg8::StaticOrder, true, true>(P.lds, g, S, E, P.wave); }
        }
        SEAM(pb + 4);
        if (IN(pb + 5)) { PHASE_PTRS
            for (int rep = 0; rep < ((PROBE_DUP >> 5) & 1) + 1; ++rep) {
            { pg8::Gemm g{HBc, (const bf16*)(wl + WO_PG), M, D, D}; pg8::StaticOrder S; S.init(M, D, P.G, bid, 4);
              pg8::EpiPle E{HBc, HBn, PP, SS0, SS2};
              pg8::gemm_phase<pg8::EpiPle, pg8::StaticOrder, true, true>(P.lds, g, S, E, P.wave); }
            }
        }
        SEAM(pb + 5);
    }
    if (IN(NPHASE - 1)) {
        const Frame P = phase_frame(F);
        const int lane = lane_opaque();
        const float* fg = args.in[23];
        const bf16* HBf = (const bf16*)(P.ws + ((DEPTH & 1) ? WS_HB1 : WS_HB0));
        f32x4 gv[4][2];
#pragma unroll
        for (int j = 0; j < 4; ++j) { gv[j][0] = *(const GAS f32x4*)(fg + 512 * j + 8 * lane); gv[j][1] = *(const GAS f32x4*)(fg + 512 * j + 8 * lane + 4); }
        for (int m = P.gw; m < M; m += P.NGW) {
            const bf16* hr = HBf + (size_t)m * D + 8 * lane; float* orow = (float*)P.out + (size_t)m * D + 8 * lane;
            float v[4][8]; float q = 0.f;
#pragma unroll
            for (int j = 0; j < 4; ++j) { unpack8(*(const GAS v4u*)(hr + 512 * j), v[j]);
#pragma unroll
                for (int e = 0; e < 8; ++e) q += v[j][e] * v[j][e]; }
            const float rs = __builtin_amdgcn_rsqf(wave_sum(q) * (1.0f / D) + EPS);
#pragma unroll
            for (int j = 0; j < 4; ++j) { f32x4 o0, o1;
#pragma unroll
                for (int e = 0; e < 4; ++e) { o0[e] = v[j][e] * rs * gv[j][0][e]; o1[e] = v[j][4 + e] * rs * gv[j][1][e]; }
                *(GAS f32x4*)(orow + 512 * j) = o0; *(GAS f32x4*)(orow + 512 * j + 4) = o1; }
        }
    }
#undef IN
#undef SEAM
}

extern "C" void kernel_launch(void* const* d_in, const int* in_sizes, int n_in, void* d_out, int out_size, void* d_ws, size_t ws_size, hipStream_t stream) {
    static int grid = 0;
    if (grid == 0) {
        if (n_in != 24 || in_sizes[0] != M * D || out_size != M * D || ws_size < WS_END) {
            fprintf(stderr, "kernel_launch: built for 24 inputs, x/out of %d floats, >= %zu bytes of workspace; got n_in %d, in0 %d, out %d, ws %zu; nothing launched\n", M * D, (size_t)WS_END, n_in, n_in > 0 ? in_sizes[0] : -1, out_size, ws_size);
            grid = -1; return; }
        int dev = 0, cus = 0, per_cu = 0;
        if (hipGetDevice(&dev) != hipSuccess || hipDeviceGetAttribute(&cus, hipDeviceAttributeMultiprocessorCount, dev) != hipSuccess) { fprintf(stderr, "kernel_launch: device query failed\n"); grid = -1; return; }
        if (hipFuncSetAttribute((const void*)trunk_fwd, hipFuncAttributeMaxDynamicSharedMemorySize, LDS_BYTES) != hipSuccess) { fprintf(stderr, "kernel_launch: hipFuncSetAttribute failed\n"); grid = -1; return; }
        if (hipOccupancyMaxActiveBlocksPerMultiprocessor(&per_cu, (const void*)trunk_fwd, NTHR, LDS_BYTES) != hipSuccess || per_cu < 1) { fprintf(stderr, "kernel_launch: occupancy query says %d blocks per CU; nothing launched\n", per_cu); (void)hipGetLastError(); grid = -1; return; }
        grid = cus;
    }
    if (grid < 0) return;
    (void)hipMemsetAsync((char*)d_ws + WS_CTL, 0, CTL_ZERO_BYTES, stream);
    Args a{};
    for (int i = 0; i < 24; ++i) a.in[i] = (const float*)d_in[i];
    a.out = (float*)d_out; a.ws = (unsigned char*)d_ws;
#if MK_N_LAUNCHES == 1
    a.ph_lo = 0; a.ph_hi = NPHASE;
    hipLaunchKernelGGL(trunk_fwd, dim3(grid), dim3(NTHR), LDS_BYTES, stream, a);
#else
    for (int ph = 0; ph < NPHASE; ++ph) { a.ph_lo = ph; a.ph_hi = ph + 1; hipLaunchKernelGGL(trunk_fwd, dim3(grid), dim3(NTHR), LDS_BYTES, stream, a); }
#endif
    const hipError_t le = hipPeekAtLastError();
    if (le != hipSuccess) fprintf(stderr, "kernel_launch: launch failed: %s\n", hipGetErrorName(le));
}
```

```cpp
#include <hip/hip_runtime.h>
#include <cstdio>
#include <cstdint>

#ifndef PROBE_DUP
#define PROBE_DUP 0
#endif
#ifndef MK_N_LAUNCHES
#define MK_N_LAUNCHES 1
#endif

namespace pg8 {
#define PG8_LAS __attribute__((address_space(3)))
typedef unsigned short bf16_t;
typedef short bf16x8 __attribute__((ext_vector_type(8)));
typedef float f32x4 __attribute__((ext_vector_type(4)));
typedef unsigned u32x4 __attribute__((ext_vector_type(4)));
typedef unsigned u32x2 __attribute__((ext_vector_type(2)));
constexpr int BM = 256, BK = 64, HALF = 128, HTB = HALF * BK * 2  , STAGE_BYTES = 8 * HTB, NXCD = 8, WGM = 8;
constexpr int RS_OFF = STAGE_BYTES;

__host__ __device__ __forceinline__ int lds_byte(int r, int c) { const int st = (r >> 4) * 2 + (c >> 5), rr = r & 15, cc = c & 31, ob = rr * 64 + cc * 2; return st * 1024 + (ob ^ (((ob >> 9) & 1) << 5)); }
__host__ __device__ __forceinline__ void stage_rc(int b, int& R, int& C) { const int st = b / 1024, sb = b % 1024, swz = sb ^ (((sb >> 9) & 1) << 5); R = (st >> 1) * 16 + swz / 64; C = (st & 1) * 32 + (swz % 64) / 2; }
__host__ __device__ __forceinline__ int perm32(int rho) { const int n = rho >> 4, i = rho & 15; return 8 * (i >> 2) + 4 * n + (i & 3); }

struct Unit { int pm, pn; int lm, ln; };
struct Gemm { const bf16_t* A; const bf16_t* Bt; int M, N, K; };

struct StaticOrder {
    int nM, nN, nwg, G, c, wgm, fixed = 0, rev = 0;
    __host__ __device__ void init(int M, int N, int G_, int c_, int wgm_ = WGM) { nM = M / BM; nN = N / BM; nwg = nM * nN; G = G_; c = c_; wgm = wgm_; }
    __host__ __device__ bool next(int i, Unit& u) const {
        if ((long)i * G + c >= nwg) return false;
        const long L = rev ? (long)((nwg - 1 - c) / G - i) * G + c : (long)i * G + c;
        int wgid = (int)L; { const int q = nwg / NXCD, r = nwg % NXCD, xcd = wgid % NXCD, off = wgid / NXCD; wgid = (xcd < r ? xcd * (q + 1) : r * (q + 1) + (xcd - r) * q) + off; }
        const int nig = wgm * nN, gid = wgid / nig, fm = gid * wgm, gsz = (nM - fm) < wgm ? (nM - fm) : wgm;
        u.pm = fm + ((wgid % nig) % gsz); u.pn = (wgid % nig) / gsz; u.lm = fixed ? 0 : u.pm; u.ln = fixed ? 0 : u.pn; return true;
    }
    __device__ __forceinline__ void a_ready(const Unit&) const {}
    __device__ __forceinline__ void done(const Unit&) const {}
};

struct FixedOrder : StaticOrder {
    __host__ __device__ bool next(int i, Unit& u) const { const bool ok = StaticOrder::next(i, u); u.lm = 0; u.ln = 0; return ok; }
};
typedef __bf16 bf16x2_t __attribute__((ext_vector_type(2)));
typedef float f32x2_t __attribute__((ext_vector_type(2)));
__device__ __forceinline__ unsigned cvt_pk_bf16(float lo, float hi) { return __builtin_bit_cast(unsigned, __builtin_convertvector((f32x2_t){lo, hi}, bf16x2_t)); }
__device__ __forceinline__ float sigmoid_f(float x) { return __builtin_amdgcn_rcpf(1.0f + __builtin_amdgcn_exp2f(-1.4426950408889634f * x)); }
__device__ __forceinline__ float silu_f(float x) { return x * sigmoid_f(x); }
__device__ __forceinline__ float gelu_f(float x) { return x * sigmoid_f(1.5957691216057308f * (x + 0.044715f * x * x * x)); }
__device__ __forceinline__ float bf_lo(unsigned w) { return __uint_as_float(w << 16); }
__device__ __forceinline__ float bf_hi(unsigned w) { return __uint_as_float(w & 0xffff0000u); }

template <int CTRL> __device__ __forceinline__ float dpp_f(float v) { return __int_as_float(__builtin_amdgcn_update_dpp(0, __float_as_int(v), CTRL, 0xf, 0xf, true)); }
template <int PAT> __device__ __forceinline__ float swz_f(float v) { return __int_as_float(__builtin_amdgcn_ds_swizzle(__float_as_int(v), PAT)); }
__device__ __forceinline__ float sum_xor1_2(float v) { v += dpp_f<0xB1>(v); v += dpp_f<0x4E>(v); return v; }
__device__ __forceinline__ float sum_xor16(float v) { return v + swz_f<0x401F>(v); }
__device__ __forceinline__ float sum_xor32(float v) { const auto r = __builtin_amdgcn_permlane32_swap(__float_as_uint(v), __float_as_uint(v), false, false); return __uint_as_float(r[0]) + __uint_as_float(r[1]); }
__device__ __forceinline__ float wave_sum_f(float v) { v = sum_xor1_2(v); v += dpp_f<0x124>(v); v += dpp_f<0x128>(v); v = sum_xor16(v); return sum_xor32(v); }

__device__ __forceinline__ void rs_prep(const float* ss, int pm, int parity, PG8_LAS unsigned char* lds, int tid) {
    if (tid < 256) {
        const f32x4* p = (const f32x4*)(ss + (size_t)(pm * BM + tid) * 32);
        f32x4 s = p[0];
#pragma unroll
        for (int j = 1; j < 8; ++j) s += p[j];
        const float tot = (s[0] + s[1]) + (s[2] + s[3]);
        *(PG8_LAS float*)(lds + RS_OFF + parity * 1024 + tid * 4) = __builtin_amdgcn_rsqf(tot * (1.0f / 2048.0f) + 1e-6f);
    }
    asm volatile("s_waitcnt lgkmcnt(0)" ::: "memory");
}
__device__ __forceinline__ void rs_load(float (&rs)[8], PG8_LAS unsigned char* lds, int parity, int wr, int fr) {
    const unsigned addr = (unsigned)(uintptr_t)(lds + RS_OFF + parity * 1024 + (wr * 64 + fr) * 4);
    asm volatile("ds_read_b32 %0, %8\n\tds_read_b32 %1, %8 offset:64\n\tds_read_b32 %2, %8 offset:128\n\tds_read_b32 %3, %8 offset:192\n\t"
                 "ds_read_b32 %4, %8 offset:512\n\tds_read_b32 %5, %8 offset:576\n\tds_read_b32 %6, %8 offset:640\n\tds_read_b32 %7, %8 offset:704\n\ts_waitcnt lgkmcnt(0)"
                 : "=&v"(rs[0]), "=&v"(rs[1]), "=&v"(rs[2]), "=&v"(rs[3]), "=&v"(rs[4]), "=&v"(rs[5]), "=&v"(rs[6]), "=&v"(rs[7]) : "v"(addr) : "memory");
}

template <bool SCALE> struct EpiStore {
    static constexpr bool PERM = true, AFTER_DRAIN = false, HAS_PREP = SCALE;
    bf16_t* O; int ldc; const float* ss;
    __device__ __forceinline__ void prep(const Unit& u, int parity, PG8_LAS unsigned char* lds, int tid) const { rs_prep(ss, u.pm, parity, lds, tid); }
    __device__ __forceinline__ void operator()(const f32x4 (&acc)[2][2][4][2], const Unit& u, int wr, int wc, int fr, int fq, PG8_LAS unsigned char* lds, int parity) const {
        float rs[8];
        if constexpr (SCALE) rs_load(rs, lds, parity, wr, fr);
        const int row0 = u.pm * BM + wr * 64 + fr, col0 = u.pn * BM + wc * 32 + 8 * fq;
#pragma unroll
        for (int ai = 0; ai < 2; ++ai)
#pragma unroll
            for (int m = 0; m < 4; ++m) { bf16_t* rowp = O + (size_t)(row0 + ai * HALF + m * 16) * ldc + col0; const float s = SCALE ? rs[ai * 4 + m] : 1.0f;
#pragma unroll
                for (int bj = 0; bj < 2; ++bj) { const f32x4 v0 = acc[ai][bj][m][0] * s, v1 = acc[ai][bj][m][1] * s;
                    u32x4 w; w.x = cvt_pk_bf16(v0[0], v0[1]); w.y = cvt_pk_bf16(v0[2], v0[3]); w.z = cvt_pk_bf16(v1[0], v1[1]); w.w = cvt_pk_bf16(v1[2], v1[3]);
                    *(u32x4*)(rowp + bj * HALF) = w; } }
    }
};
struct EpiG1 {
    static constexpr bool PERM = true, AFTER_DRAIN = false, HAS_PREP = true;
    bf16_t* O; const float* ss;
    static constexpr int LDO = 3072;
    __device__ __forceinline__ void prep(const Unit& u, int parity, PG8_LAS unsigned char* lds, int tid) const { rs_prep(ss, u.pm, parity, lds, tid); }
    __device__ __forceinline__ void operator()(const f32x4 (&acc)[2][2][4][2], const Unit& u, int wr, int wc, int fr, int fq, PG8_LAS unsigned char* lds, int parity) const {
        float rs[8]; rs_load(rs, lds, parity, wr, fr);
        const int row0 = u.pm * BM + wr * 64 + fr, lc = wc * 32 + 8 * fq, pn = u.pn;
        const bool pair = (pn >= 4 && pn < 8) || (pn >= 10 && pn < 14);
        if (!pair) {
            const int col0 = (pn < 4 ? 256 * pn : pn < 10 ? 1536 + 256 * (pn - 8) : 2560 + 256 * (pn - 14)) + lc; const bool act = pn < 4;
#pragma unroll
            for (int ai = 0; ai < 2; ++ai)
#pragma unroll
                for (int m = 0; m < 4; ++m) { bf16_t* rowp = O + (size_t)(row0 + ai * HALF + m * 16) * LDO + col0; const float s = rs[ai * 4 + m];
#pragma unroll
                    for (int bj = 0; bj < 2; ++bj) { f32x4 v0 = acc[ai][bj][m][0] * s, v1 = acc[ai][bj][m][1] * s;
                        if (act) {
#pragma unroll
                            for (int j = 0; j < 4; ++j) { v0[j] = gelu_f(v0[j]); v1[j] = gelu_f(v1[j]); } }
                        u32x4 w; w.x = cvt_pk_bf16(v0[0], v0[1]); w.y = cvt_pk_bf16(v0[2], v0[3]); w.z = cvt_pk_bf16(v1[0], v1[1]); w.w = cvt_pk_bf16(v1[2], v1[3]);
                        *(u32x4*)(rowp + bj * HALF) = w; } }
        } else {
            const int col0 = (pn < 8 ? 1024 + 128 * (pn - 4) : 2048 + 128 * (pn - 10)) + lc; const bool glu = pn >= 10;
#pragma unroll
            for (int ai = 0; ai < 2; ++ai)
#pragma unroll
                for (int m = 0; m < 4; ++m) { bf16_t* rowp = O + (size_t)(row0 + ai * HALF + m * 16) * LDO + col0; const float s = rs[ai * 4 + m];
                    float o[8];
#pragma unroll
                    for (int n = 0; n < 2; ++n)
#pragma unroll
                        for (int j = 0; j < 4; ++j) { const float a = acc[ai][0][m][n][j] * s, b = acc[ai][1][m][n][j] * s; o[n * 4 + j] = a * (glu ? sigmoid_f(b) : b); }
                    u32x4 w; w.x = cvt_pk_bf16(o[0], o[1]); w.y = cvt_pk_bf16(o[2], o[3]); w.z = cvt_pk_bf16(o[4], o[5]); w.w = cvt_pk_bf16(o[6], o[7]);
                    *(u32x4*)rowp = w; }
        }
    }
};
struct EpiSwiGLU {
    static constexpr bool PERM = true, AFTER_DRAIN = false, HAS_PREP = true;
    bf16_t* T; int ldt; const float* ss;
    __device__ __forceinline__ void prep(const Unit& u, int parity, PG8_LAS unsigned char* lds, int tid) const { rs_prep(ss, u.pm, parity, lds, tid); }
    __device__ __forceinline__ void operator()(const f32x4 (&acc)[2][2][4][2], const Unit& u, int wr, int wc, int fr, int fq, PG8_LAS unsigned char* lds, int parity) const {
        float rs[8]; rs_load(rs, lds, parity, wr, fr);
        const int row0 = u.pm * BM + wr * 64 + fr, col0 = u.pn * HALF + wc * 32 + 8 * fq;
#pragma unroll
        for (int ai = 0; ai < 2; ++ai)
#pragma unroll
            for (int m = 0; m < 4; ++m) { bf16_t* rowp = T + (size_t)(row0 + ai * HALF + m * 16) * ldt + col0; const float s = rs[ai * 4 + m];
                float o[8];
#pragma unroll
                for (int n = 0; n < 2; ++n)
#pragma unroll
                    for (int j = 0; j < 4; ++j) { const float g = acc[ai][0][m][n][j] * s, uu = acc[ai][1][m][n][j] * s; o[n * 4 + j] = silu_f(g) * uu; }
                u32x4 w; w.x = cvt_pk_bf16(o[0], o[1]); w.y = cvt_pk_bf16(o[2], o[3]); w.z = cvt_pk_bf16(o[4], o[5]); w.w = cvt_pk_bf16(o[6], o[7]);
                *(u32x4*)rowp = w; }
    }
};
struct EpiRes {
    static constexpr bool PERM = true, AFTER_DRAIN = false, HAS_PREP = false;
    bf16_t* HB; float* SSo;
    __device__ __forceinline__ void prep(const Unit&, int, PG8_LAS unsigned char*, int) const {}
    __device__ __forceinline__ void operator()(const f32x4 (&acc)[2][2][4][2], const Unit& u, int wr, int wc, int fr, int fq, PG8_LAS unsigned char*, int) const {
        const int row0 = u.pm * BM + wr * 64 + fr, col0 = u.pn * BM + wc * 32 + 8 * fq;
        bf16_t* const base = HB + (size_t)row0 * 2048 + col0;
        u32x4 old[2][4][2];
#pragma unroll
        for (int ai = 0; ai < 2; ++ai)
#pragma unroll
            for (int m = 0; m < 4; ++m)
#pragma unroll
                for (int bj = 0; bj < 2; ++bj) old[ai][m][bj] = *(const u32x4*)(base + (size_t)(ai * HALF + m * 16) * 2048 + bj * HALF);
#pragma unroll
        for (int ai = 0; ai < 2; ++ai)
#pragma unroll
            for (int m = 0; m < 4; ++m) { const int row = row0 + ai * HALF + m * 16; float q = 0.f;
#pragma unroll
                for (int bj = 0; bj < 2; ++bj) { const u32x4 o = old[ai][m][bj]; const f32x4 a0 = acc[ai][bj][m][0], a1 = acc[ai][bj][m][1];
                    const float h0 = bf_lo(o.x) + a0[0], h1 = bf_hi(o.x) + a0[1], h2 = bf_lo(o.y) + a0[2], h3 = bf_hi(o.y) + a0[3], h4 = bf_lo(o.z) + a1[0], h5 = bf_hi(o.z) + a1[1], h6 = bf_lo(o.w) + a1[2], h7 = bf_hi(o.w) + a1[3];
                    u32x4 w; w.x = cvt_pk_bf16(h0, h1); w.y = cvt_pk_bf16(h2, h3); w.z = cvt_pk_bf16(h4, h5); w.w = cvt_pk_bf16(h6, h7);
                    *(u32x4*)(base + (size_t)(ai * HALF + m * 16) * 2048 + bj * HALF) = w;
                    q += (h0 * h0 + h1 * h1) + (h2 * h2 + h3 * h3) + (h4 * h4 + h5 * h5) + (h6 * h6 + h7 * h7); }
                q = sum_xor32(sum_xor16(q));
                if (fq == 0) SSo[(size_t)row * 32 + u.pn * 4 + wc] = q; }
    }
};
struct EpiPle {
    static constexpr bool PERM = true, AFTER_DRAIN = false, HAS_PREP = true;
    const bf16_t* HBi; bf16_t* HBo; const bf16_t* PP; float* SSo; const float* ss;
    __device__ __forceinline__ void prep(const Unit& u, int parity, PG8_LAS unsigned char* lds, int tid) const { rs_prep(ss, u.pm, parity, lds, tid); }
    __device__ __forceinline__ void operator()(const f32x4 (&acc)[2][2][4][2], const Unit& u, int wr, int wc, int fr, int fq, PG8_LAS unsigned char* lds, int parity) const {
        float rs[8]; rs_load(rs, lds, parity, wr, fr);
        const int row0 = u.pm * BM + wr * 64 + fr, col0 = u.pn * BM + wc * 32 + 8 * fq;
        const size_t off0 = (size_t)row0 * 2048 + col0;
#pragma unroll
        for (int ai = 0; ai < 2; ++ai) {
            u32x4 old[4][2], ppv[4][2];
#pragma unroll
            for (int m = 0; m < 4; ++m)
#pragma unroll
                for (int bj = 0; bj < 2; ++bj) { const size_t o = off0 + (size_t)(ai * HALF + m * 16) * 2048 + bj * HALF; old[m][bj] = *(const u32x4*)(HBi + o); ppv[m][bj] = *(const u32x4*)(PP + o); }
#pragma unroll
            for (int m = 0; m < 4; ++m) { const int row = row0 + ai * HALF + m * 16; const float s = rs[ai * 4 + m]; float q = 0.f;
#pragma unroll
                for (int bj = 0; bj < 2; ++bj) { const u32x4 o = old[m][bj], pw = ppv[m][bj]; const f32x4 a0 = acc[ai][bj][m][0] * s, a1 = acc[ai][bj][m][1] * s;
                    const float h0 = bf_lo(o.x) + sigmoid_f(a0[0]) * bf_lo(pw.x), h1 = bf_hi(o.x) + sigmoid_f(a0[1]) * bf_hi(pw.x), h2 = bf_lo(o.y) + sigmoid_f(a0[2]) * bf_lo(pw.y), h3 = bf_hi(o.y) + sigmoid_f(a0[3]) * bf_hi(pw.y);
                    const float h4 = bf_lo(o.z) + sigmoid_f(a1[0]) * bf_lo(pw.z), h5 = bf_hi(o.z) + sigmoid_f(a1[1]) * bf_hi(pw.z), h6 = bf_lo(o.w) + sigmoid_f(a1[2]) * bf_lo(pw.w), h7 = bf_hi(o.w) + sigmoid_f(a1[3]) * bf_hi(pw.w);
                    u32x4 w; w.x = cvt_pk_bf16(h0, h1); w.y = cvt_pk_bf16(h2, h3); w.z = cvt_pk_bf16(h4, h5); w.w = cvt_pk_bf16(h6, h7);
                    *(u32x4*)(HBo + off0 + (size_t)(ai * HALF + m * 16) * 2048 + bj * HALF) = w;
                    q += (h0 * h0 + h1 * h1) + (h2 * h2 + h3 * h3) + (h4 * h4 + h5 * h5) + (h6 * h6 + h7 * h7); }
                q = sum_xor32(sum_xor16(q));
                if (fq == 0) SSo[(size_t)row * 32 + u.pn * 4 + wc] = q; }
        }
    }
};

template <class Epi, class Sched, bool ALIGN_EPI = false, bool SP2 = false>
__device__ __forceinline__ void gemm_phase(PG8_LAS unsigned char* lds, const Gemm g, const Sched& S, const Epi& E, const int wave_id) {
    int lane_; asm volatile("v_mbcnt_lo_u32_b32 %0, -1, 0\n\tv_mbcnt_hi_u32_b32 %0, -1, %0" : "=v"(lane_));
    const int wid = wave_id, lane = (int)lane_, tid = wid * 64 + lane, wr = wid >> 2, wc = wid & 3, fr = lane & 15, fq = lane >> 4;
    const int K = g.K, nt = K / BK;
    unsigned voffA[2], voffB[2];
#pragma unroll
    for (int i = 0; i < 2; ++i) { int R, C; stage_rc(tid * 16 + i * 8192, R, C); const int Rb = Epi::PERM ? ((R & ~31) + perm32(R & 31)) : R;
        voffA[i] = (unsigned)(R * K + C) * 2u; voffB[i] = (unsigned)(Rb * K + C) * 2u; }
    const size_t kstep = (size_t)(BK * 2);
    const size_t hstep = (size_t)HALF * K * 2;
    const size_t tstep = 2 * hstep;
    const unsigned ldsw = (unsigned)wid * 1024u;
    const int aoff = lds_byte(wr * 64 + fr, fq * 8), boff = lds_byte(wc * 32 + fr, fq * 8);
#define PG8_SA(b, h) (((b) * 2 + (h)) * HTB)
#define PG8_SB(b, h) ((4 + (b) * 2 + (h)) * HTB)
#define PG8_STAGE(bufoff, gbase, voff) do { _Pragma("unroll") for (int _i = 0; _i < 2; ++_i) \
        __builtin_amdgcn_global_load_lds((const unsigned*)((const char*)(gbase) + (voff)[_i]), (PG8_LAS unsigned*)(lds + (bufoff) + ldsw + _i * 8192), 16, 0, 0); } while (0)
#define PG8_LDA(dst, b, h) do { _Pragma("unroll") for (int m = 0; m < 4; ++m) _Pragma("unroll") for (int k = 0; k < 2; ++k) dst[m][k] = *(const PG8_LAS bf16x8*)(lds + PG8_SA(b, h) + aoff + m * 2048 + k * 1024); } while (0)
#define PG8_LDB(dst, b, h) do { _Pragma("unroll") for (int n = 0; n < 2; ++n) _Pragma("unroll") for (int k = 0; k < 2; ++k) dst[n][k] = *(const PG8_LAS bf16x8*)(lds + PG8_SB(b, h) + boff + n * 2048 + k * 1024); } while (0)
#define PG8_MMA(ai, bj, At, Bt) do { __builtin_amdgcn_s_setprio(1); _Pragma("unroll") for (int m = 0; m < 4; ++m) _Pragma("unroll") for (int n = 0; n < 2; ++n) _Pragma("unroll") for (int k = 0; k < 2; ++k) \
        acc[ai][bj][m][n] = __builtin_amdgcn_mfma_f32_16x16x32_bf16(Bt[n][k], At[m][k], acc[ai][bj][m][n], 0, 0, 0); __builtin_amdgcn_s_setprio(0); } while (0)
#define PG8_WAIT_V(n) asm volatile("s_waitcnt vmcnt(" #n ")" ::: "memory")
#define PG8_WAIT_L(n) asm volatile("s_waitcnt lgkmcnt(" #n ")" ::: "memory")
#define PG8_BAR __builtin_amdgcn_s_barrier()
#define PG8_SCHED __builtin_amdgcn_sched_barrier(0)
    Unit cur, nxt; int ui = 0, tp = 0;
    if (!S.next(0, cur)) return;
    f32x4 acc[2][2][4][2];
#pragma unroll
    for (int a = 0; a < 2; ++a)
#pragma unroll
        for (int b = 0; b < 2; ++b)
#pragma unroll
            for (int m = 0; m < 4; ++m)
#pragma unroll
                for (int n = 0; n < 2; ++n) acc[a][b][m][n] = (f32x4){0.f, 0.f, 0.f, 0.f};
    bf16x8 At[4][2], B0[2][2], B1[2][2];
    const char* cA = (const char*)g.A + (size_t)cur.lm * tstep; const char* cB = (const char*)g.Bt + (size_t)cur.ln * tstep;
    if constexpr (Epi::HAS_PREP) E.prep(cur, 0, lds, tid);
    S.a_ready(cur);
    if constexpr (SP2) {
        PG8_STAGE(PG8_SB(0, 0), cB, voffB); PG8_STAGE(PG8_SB(0, 1), cB + hstep, voffB); PG8_STAGE(PG8_SA(0, 0), cA, voffA); PG8_STAGE(PG8_SA(0, 1), cA + hstep, voffA);
        if (wr == 1) PG8_BAR;
        PG8_WAIT_V(2); PG8_BAR;
        PG8_STAGE(PG8_SB(1, 0), cB + kstep, voffB); PG8_STAGE(PG8_SA(1, 0), cA + kstep, voffA); PG8_STAGE(PG8_SB(1, 1), cB + hstep + kstep, voffB);
        PG8_WAIT_V(6); PG8_BAR;
    } else {
        PG8_STAGE(PG8_SB(0, 0), cB, voffB); PG8_STAGE(PG8_SA(0, 0), cA, voffA); PG8_STAGE(PG8_SB(0, 1), cB + hstep, voffB); PG8_STAGE(PG8_SA(0, 1), cA + hstep, voffA);
        if (wr == 1) PG8_BAR;
        PG8_WAIT_V(4); PG8_BAR;
        PG8_STAGE(PG8_SB(1, 0), cB + kstep, voffB); PG8_STAGE(PG8_SA(1, 0), cA + kstep, voffA); PG8_STAGE(PG8_SB(1, 1), cB + hstep + kstep, voffB);
        PG8_WAIT_V(6); PG8_BAR;
    }
    for (;;) {
        const bool has_next = S.next(ui + 1, nxt);
        const char* nA = has_next ? (const char*)g.A + (size_t)nxt.lm * tstep : cA; const char* nB = has_next ? (const char*)g.Bt + (size_t)nxt.ln * tstep : cB;
#pragma unroll 1
        for (int t = 0; t < nt; t += 2) {
            const bool last = (t == nt - 2);
            const char* a1 = cA + (size_t)(t + 1) * kstep;
            const char* a2 = last ? nA : cA + (size_t)(t + 2) * kstep; const char* b2 = last ? nB : cB + (size_t)(t + 2) * kstep;
            const char* a3 = a2 + kstep; const char* b3 = b2 + kstep;
            if (last && has_next) S.a_ready(nxt);
            if constexpr (SP2) {
            PG8_LDB(B0, 0, 0); PG8_LDB(B1, 0, 1); PG8_SCHED; PG8_LDA(At, 0, 0); PG8_STAGE(PG8_SA(1, 1), a1 + hstep, voffA);
            PG8_WAIT_V(8); PG8_WAIT_L(0); PG8_BAR; PG8_MMA(0, 0, At, B0); PG8_MMA(0, 1, At, B1); PG8_BAR; PG8_SCHED;
            PG8_LDA(At, 0, 1); PG8_STAGE(PG8_SB(0, 0), b2, voffB); PG8_STAGE(PG8_SB(0, 1), b2 + hstep, voffB); PG8_STAGE(PG8_SA(0, 0), a2, voffA);
            PG8_WAIT_V(8); PG8_WAIT_L(0); PG8_BAR; PG8_MMA(1, 0, At, B0); PG8_MMA(1, 1, At, B1); PG8_BAR; PG8_SCHED;
            PG8_LDB(B0, 1, 0); PG8_LDB(B1, 1, 1); PG8_SCHED; PG8_LDA(At, 1, 0); PG8_STAGE(PG8_SA(0, 1), a2 + hstep, voffA);
            PG8_WAIT_V(8); PG8_WAIT_L(0); PG8_BAR; PG8_MMA(0, 0, At, B0); PG8_MMA(0, 1, At, B1); PG8_BAR; PG8_SCHED;
            PG8_LDA(At, 1, 1); PG8_STAGE(PG8_SB(1, 0), b3, voffB); PG8_STAGE(PG8_SB(1, 1), b3 + hstep, voffB); PG8_STAGE(PG8_SA(1, 0), a3, voffA);
            PG8_WAIT_V(8); PG8_WAIT_L(0); PG8_BAR; PG8_MMA(1, 0, At, B0); PG8_MMA(1, 1, At, B1); PG8_BAR; PG8_SCHED;
            } else {
            PG8_LDB(B0, 0, 0); PG8_SCHED; PG8_LDA(At, 0, 0); PG8_STAGE(PG8_SA(1, 1), a1 + hstep, voffA);
            PG8_WAIT_L(8); PG8_BAR; PG8_WAIT_L(0); PG8_MMA(0, 0, At, B0); PG8_BAR; PG8_SCHED;
            PG8_LDB(B1, 0, 1); PG8_STAGE(PG8_SB(0, 0), b2, voffB);
            PG8_BAR; PG8_WAIT_L(0); PG8_MMA(0, 1, At, B1); PG8_BAR;
            PG8_LDA(At, 0, 1); PG8_STAGE(PG8_SA(0, 0), a2, voffA);
            PG8_BAR; PG8_WAIT_L(0); PG8_MMA(1, 0, At, B0); PG8_BAR; PG8_SCHED;
            PG8_STAGE(PG8_SB(0, 1), b2 + hstep, voffB);
            PG8_WAIT_V(6); PG8_BAR; PG8_MMA(1, 1, At, B1); PG8_BAR;
            PG8_LDB(B0, 1, 0); PG8_SCHED; PG8_LDA(At, 1, 0); PG8_STAGE(PG8_SA(0, 1), a2 + hstep, voffA);
            PG8_WAIT_L(8); PG8_BAR; PG8_WAIT_L(0); PG8_MMA(0, 0, At, B0); PG8_BAR; PG8_SCHED;
            PG8_LDB(B1, 1, 1); PG8_STAGE(PG8_SB(1, 0), b3, voffB);
            PG8_BAR; PG8_WAIT_L(0); PG8_MMA(0, 1, At, B1); PG8_BAR;
            PG8_LDA(At, 1, 1); PG8_STAGE(PG8_SA(1, 0), a3, voffA);
            PG8_BAR; PG8_WAIT_L(0); PG8_MMA(1, 0, At, B0); PG8_BAR; PG8_SCHED;
            PG8_STAGE(PG8_SB(1, 1), b3 + hstep, voffB);
            PG8_WAIT_V(6); PG8_BAR; PG8_MMA(1, 1, At, B1); PG8_BAR;
            }
        }
        if constexpr (ALIGN_EPI) { if (wr == 0) PG8_BAR; }
        const bool newpanel = has_next && (nxt.pm != cur.pm);
        if constexpr (Epi::HAS_PREP) { if (newpanel) E.prep(nxt, tp ^ 1, lds, tid); }
        E(acc, cur, wr, wc, fr, fq, lds, tp); S.done(cur);
        if (!has_next) break;
        if (newpanel) tp ^= 1;
#pragma unroll
        for (int a = 0; a < 2; ++a)
#pragma unroll
            for (int b = 0; b < 2; ++b)
#pragma unroll
                for (int m = 0; m < 4; ++m)
#pragma unroll
                    for (int n = 0; n < 2; ++n) acc[a][b][m][n] = (f32x4){0.f, 0.f, 0.f, 0.f};
        cur = nxt; cA = nA; cB = nB; ++ui;
        if constexpr (ALIGN_EPI) { if (wr == 1) PG8_BAR; }
    }
    PG8_WAIT_V(0);
    if constexpr (!ALIGN_EPI) { if (wr == 0) PG8_BAR; }
    PG8_BAR;
#undef PG8_SA
#undef PG8_SB
#undef PG8_STAGE
#undef PG8_LDA
#undef PG8_LDB
#undef PG8_MMA
#undef PG8_WAIT_V
#undef PG8_WAIT_L
#undef PG8_BAR
#undef PG8_SCHED
}
}

constexpr int NWAVES = 8, NTHR = NWAVES * 64;
constexpr int BATCH = 8, SEQ = 4096, D = 2048, DEPTH = 4, M = BATCH * SEQ;
constexpr int GW = 512, INC = 4096, ZC = 3072, FF = 5632, PLE = 256, CONVK = 31;
constexpr int NPHASE = 2 + 6 * DEPTH;
constexpr float EPS = 1e-6f;

constexpr size_t MiB = 1u << 20;
constexpr size_t WS_CTL = 0, CTL_ZERO_BYTES = 32 * 1024;
constexpr size_t WS_WSB = 1 * MiB;
constexpr size_t WS_PWT = WS_WSB + 512 * 1024;
constexpr size_t WS_SS = 2 * MiB, SS_BYTES = (size_t)M * 32 * 4;
constexpr size_t WS_W = 16 * MiB, W_LAYER = 99 * MiB;
constexpr size_t WO_IN = 0, WO_OUT = 16 * MiB, WO_GU = 24 * MiB, WO_D = 68 * MiB, WO_PG = 90 * MiB, WO_PP = 98 * MiB;
constexpr size_t WS_PBF = WS_W + DEPTH * W_LAYER;
constexpr size_t WS_HB0 = WS_PBF + 64 * MiB, WS_HB1 = WS_HB0 + 128 * MiB;
constexpr size_t WS_R = WS_HB1 + 128 * MiB;
constexpr size_t WS_Z = WS_R, WS_MIX = WS_R + 256 * MiB, WS_T = WS_R, WS_PP = WS_R;
constexpr size_t WS_END = WS_R + 384 * MiB;
static_assert(WS_SS + 3 * SS_BYTES <= WS_W && (size_t)M * FF * 2 <= 384 * MiB && WS_PBF == 412 * MiB && WS_END == 1116 * MiB, "d_ws map");
constexpr int CW_BAR = 4096;
static_assert((CW_BAR + 3456) * 4 <= (int)CTL_ZERO_BYTES, "barrier words inside the memset block");

constexpr int RING_BYTES = 131072;
constexpr int LDSCTL_OFF = RING_BYTES + 2048;
constexpr int MISC_OFF = LDSCTL_OFF + 320;
constexpr int LDS_BYTES = 147456;
static_assert(MISC_OFF + 128 <= LDS_BYTES && pg8::RS_OFF == RING_BYTES, "LDS map");

#define GAS __attribute__((address_space(1)))
#define LAS __attribute__((address_space(3)))
typedef unsigned short bf16;
typedef unsigned v4u __attribute__((ext_vector_type(4)));
typedef unsigned v2u __attribute__((ext_vector_type(2)));
typedef float f32x4 __attribute__((ext_vector_type(4)));
typedef float f32x2 __attribute__((ext_vector_type(2)));
typedef short bf16x8 __attribute__((ext_vector_type(8)));
typedef GAS unsigned gu32;
#define RLX_AGENT __ATOMIC_RELAXED, __HIP_MEMORY_SCOPE_AGENT
using pg8::cvt_pk_bf16; using pg8::sigmoid_f; using pg8::silu_f; using pg8::gelu_f; using pg8::bf_lo; using pg8::bf_hi;

#define XB_TMO      128
#define XB_XCNT(j)  (256  + 64 * (j))
#define XB_XSUB(j)  (1280 + 64 * (j))
#define XB_XGEN(j)  (2304 + 64 * (j))
#define XB_TOP      3328
#define XB_TOPGEN   3392
#define XCD_BAR_WORDS 3456
#define XB_SPIN_CAP (1u << 18)

__device__ __forceinline__ unsigned xb_ld(unsigned* p)              { return __hip_atomic_load(p, __ATOMIC_RELAXED, __HIP_MEMORY_SCOPE_AGENT); }
__device__ __forceinline__ unsigned xb_add(unsigned* p, unsigned v) { return __hip_atomic_fetch_add(p, v, __ATOMIC_RELAXED, __HIP_MEMORY_SCOPE_AGENT); }
__device__ __forceinline__ unsigned xb_xcc_id() { return (unsigned)__builtin_amdgcn_s_getreg((3 << 11) | 20) & 0xFu; }
#define XB_SPIN(cond, bar) do { unsigned _sp = 0; while (cond) { __builtin_amdgcn_s_sleep(1); \
    if ((++_sp & 255u) == 0u) { if (xb_ld(&(bar)[XB_TMO])) break; if (_sp > XB_SPIN_CAP) { atomicAdd(&(bar)[XB_TMO], 1u); break; } } } } while (0)

__device__ __forceinline__ int lane_id() { return (int)__builtin_amdgcn_mbcnt_hi(~0u, __builtin_amdgcn_mbcnt_lo(~0u, 0u)); }
struct XcdBarrier {
    unsigned* bar; unsigned x;
    volatile LAS unsigned* st;
    int wave;
};
__device__ __forceinline__ int lane_opaque() { int l; asm volatile("v_mbcnt_lo_u32_b32 %0, -1, 0\n\tv_mbcnt_hi_u32_b32 %0, -1, %0" : "=v"(l)); return l; }
#define XB_THREAD0(w) ((w) == 0 && lane_opaque() == 0)
__device__ __forceinline__ XcdBarrier xcd_barrier_post(unsigned* bar, volatile LAS unsigned* st, int wave) {
    XcdBarrier b; b.bar = bar; b.x = xb_xcc_id(); b.st = st; b.wave = wave;
    if (XB_THREAD0(wave)) (void)xb_add(&bar[XB_XCNT(b.x)], 1u);
    return b;
}
__device__ __forceinline__ void xcd_barrier_complete(unsigned* bar, unsigned x, unsigned& nloc, unsigned& nx) {
    const unsigned G = gridDim.x * gridDim.y * gridDim.z;
    unsigned sum, cnt, mine, sp = 0u;
    for (;;) {
        sum = 0u; cnt = 0u; mine = 0u;
#pragma unroll
        for (unsigned j = 0; j < 16; ++j) { const unsigned c = xb_ld(&bar[XB_XCNT(j)]); sum += c; cnt += (c > 0u) ? 1u : 0u; mine = (j == x) ? c : mine; }
        if (sum == G) break;
        __builtin_amdgcn_s_sleep(1);
        if ((++sp & 255u) == 0u) { if (xb_ld(&bar[XB_TMO])) break; if (sp > XB_SPIN_CAP) { atomicAdd(&bar[XB_TMO], 1u); break; } }
    }
    nloc = mine > 0u ? mine : 1u; nx = cnt > 0u ? cnt : 1u;
}
__device__ __forceinline__ void xcd_barrier(const XcdBarrier& b) {
    asm volatile("s_waitcnt vmcnt(0)" ::: "memory");
    __syncthreads();
    if (XB_THREAD0(b.wave)) {
        unsigned* bar = b.bar;
        __builtin_amdgcn_s_waitcnt(0);
        unsigned nloc = b.st[0], nx = b.st[1];
        if (nloc == 0u) { xcd_barrier_complete(bar, b.x, nloc, nx); b.st[0] = nloc; b.st[1] = nx; }
        const unsigned old = xb_add(&bar[XB_XSUB(b.x)], 1u);
        const unsigned gen = old / nloc;
        if (old + 1u == (gen + 1u) * nloc) {
            __builtin_amdgcn_fence(__ATOMIC_RELEASE, "agent");
            asm volatile("s_waitcnt vmcnt(0)" ::: "memory");
            const unsigned og = xb_add(&bar[XB_TOP], 1u);
            const unsigned tg = og / nx;
            if (og + 1u == (tg + 1u) * nx) xb_add(&bar[XB_TOPGEN], 1u);
            else XB_SPIN(xb_ld(&bar[XB_TOPGEN]) == tg, bar);
            __builtin_amdgcn_fence(__ATOMIC_ACQUIRE, "agent");
            xb_add(&bar[XB_XGEN(b.x)], 1u);
            asm volatile("s_waitcnt vmcnt(0)" ::: "memory");
        } else {
            XB_SPIN(xb_ld(&bar[XB_XGEN(b.x)]) == gen, bar);
            __builtin_amdgcn_fence(__ATOMIC_ACQUIRE, "agent");
            asm volatile("s_waitcnt vmcnt(0)" ::: "memory");
        }
    }
    __syncthreads();
}

struct Args {
    const float* in[24]; float* out; unsigned char* ws; int ph_lo, ph_hi;
};
struct Frame {
    LAS unsigned char* lds;
    int wave, G, gw, NGW;
    GAS float* out; GAS unsigned char* ws;
};
__device__ __forceinline__ Frame phase_frame(const Frame& F) { Frame P = F; asm volatile("" : "+s"(P.wave), "+s"(P.gw), "+s"(P.ws), "+s"(P.out)); return P; }
__device__ __forceinline__ float wave_sum(float v) { return pg8::wave_sum_f(v); }
__device__ __forceinline__ void unpack8(const v4u w, float (&f)[8]) { f[0] = bf_lo(w.x); f[1] = bf_hi(w.x); f[2] = bf_lo(w.y); f[3] = bf_hi(w.y); f[4] = bf_lo(w.z); f[5] = bf_hi(w.z); f[6] = bf_lo(w.w); f[7] = bf_hi(w.w); }
__device__ __forceinline__ v4u pack8(const float (&f)[8]) { v4u w; w.x = cvt_pk_bf16(f[0], f[1]); w.y = cvt_pk_bf16(f[2], f[3]); w.z = cvt_pk_bf16(f[4], f[5]); w.w = cvt_pk_bf16(f[6], f[7]); return w; }
__device__ __forceinline__ bf16 f2bf(float f) { return (bf16)(cvt_pk_bf16(f, 0.f) & 0xffffu); }

__device__ __forceinline__ void p0_transpose_item(const float* W, int ldw, int K, const float* gain, bf16* WT, int k0, int n0, int drow0, LAS float* scr, int lane) {
    float wv[32];
#pragma unroll
    for (int i = 0; i < 32; ++i) wv[i] = __builtin_nontemporal_load(W + (size_t)(k0 + 2 * i + (lane >> 5)) * ldw + n0 + (lane & 31));
    const float gk = gain ? gain[k0 + lane] : 1.0f;
#pragma unroll
    for (int i = 0; i < 32; ++i) { const int kk = 2 * i + (lane >> 5); scr[kk * 33 + (lane & 31)] = wv[i] * __shfl(gk, kk); }
    asm volatile("s_waitcnt lgkmcnt(0)" ::: "memory");
    const int c = lane & 7;
#pragma unroll
    for (int j = 0; j < 4; ++j) { const int n = (lane >> 3) + 8 * j; const LAS float* s = scr + (8 * c) * 33 + n;
        v4u o; o.x = cvt_pk_bf16(s[0 * 33], s[1 * 33]); o.y = cvt_pk_bf16(s[2 * 33], s[3 * 33]); o.z = cvt_pk_bf16(s[4 * 33], s[5 * 33]); o.w = cvt_pk_bf16(s[6 * 33], s[7 * 33]);
        *(GAS v4u*)(WT + (size_t)(drow0 + n) * K + k0 + 8 * c) = o; }
    asm volatile("s_waitcnt lgkmcnt(0)" ::: "memory");
}
__device__ __forceinline__ void p0_prologue(const Frame& F, const Args& A) {
    const int lane = lane_opaque();
    LAS float* scr = (LAS float*)(F.lds + F.wave * 16384);
    constexpr int I_IN = (D / 64) * (INC / 32), I_OUT = (D / 64) * (D / 32), I_GU = (D / 64) * (2 * FF / 32), I_D = (FF / 64) * (D / 32), I_PG = I_OUT, I_PP = (PLE / 64) * (D / 32);
    constexpr int I_LAYER = I_IN + I_OUT + I_GU + I_D + I_PG + I_PP;
    for (int it = F.gw; it < DEPTH * I_LAYER; it += F.NGW) {
        const int l = DEPTH - 1 - it / I_LAYER; int r = I_LAYER - 1 - it % I_LAYER;
        unsigned char* wl = (unsigned char*)(F.ws + WS_W + (size_t)l * W_LAYER);
        if (r < I_IN) { const int nb = INC / 32, kb = r / nb, rg = r % nb, pn = rg >> 3, j = rg & 7;
            const int src = pn < 4 ? 256 * pn + 32 * j : pn < 8 ? (j < 4 ? 1024 : 2048) + 128 * (pn - 4) + 32 * (j & 3) : pn < 10 ? 1536 + 256 * (pn - 8) + 32 * j
                          : pn < 14 ? (j < 4 ? 2560 : 3072) + 128 * (pn - 10) + 32 * (j & 3) : 3584 + 256 * (pn - 14) + 32 * j;
            p0_transpose_item(A.in[3] + (size_t)l * D * INC, INC, D, A.in[2] + l * D, (bf16*)(wl + WO_IN), 64 * kb, src, 32 * rg, scr, lane); continue; } r -= I_IN;
        if (r < I_OUT) { const int nb = D / 32, kb = r / nb, rg = r % nb;
            p0_transpose_item(A.in[15] + (size_t)l * D * D, D, D, nullptr, (bf16*)(wl + WO_OUT), 64 * kb, 32 * rg, 32 * rg, scr, lane); continue; } r -= I_OUT;
        if (r < I_GU) { const int nb = 2 * FF / 32, kb = r / nb, rg = r % nb;
            const int pn = rg >> 3, j = rg & 7; const float* src = (j < 4 ? A.in[17] : A.in[18]) + (size_t)l * D * FF;
            p0_transpose_item(src, FF, D, A.in[16] + l * D, (bf16*)(wl + WO_GU), 64 * kb, 128 * pn + 32 * (j & 3), 32 * rg, scr, lane); continue; } r -= I_GU;
        if (r < I_D) { const int nb = D / 32, kb = r / nb, rg = r % nb;
            p0_transpose_item(A.in[19] + (size_t)l * FF * D, D, FF, nullptr, (bf16*)(wl + WO_D), 64 * kb, 32 * rg, 32 * rg, scr, lane); continue; } r -= I_D;
        if (r < I_PG) { const int nb = D / 32, kb = r / nb, rg = r % nb;
            p0_transpose_item(A.in[21] + (size_t)l * D * D, D, D, A.in[20] + l * D, (bf16*)(wl + WO_PG), 64 * kb, 32 * rg, 32 * rg, scr, lane); continue; } r -= I_PG;
        { const int nb = D / 32, kb = r / nb, rg = r % nb;
            p0_transpose_item(A.in[22] + (size_t)l * PLE * D, D, PLE, nullptr, (bf16*)(wl + WO_PP), 64 * kb, 32 * rg, 32 * rg, scr, lane); }
    }
    { const float* x = A.in[0]; bf16* hb = (bf16*)(F.ws + WS_HB0); float* ss = (float*)(F.ws + WS_SS);
        for (int m = F.gw; m < M; m += F.NGW) {
            const GAS f32x4* xr = (const GAS f32x4*)(x + (size_t)m * D) + lane;
            GAS v2u* hrow = (GAS v2u*)(hb + (size_t)m * D) + lane;
            f32x4 v[8]; float q = 0.f;
#pragma unroll
            for (int j = 0; j < 8; ++j) v[j] = __builtin_nontemporal_load(xr + 64 * j);
#pragma unroll
            for (int j = 0; j < 8; ++j) { v2u w; w.x = cvt_pk_bf16(v[j][0], v[j][1]); w.y = cvt_pk_bf16(v[j][2], v[j][3]); hrow[64 * j] = w;
                q += (v[j][0] * v[j][0] + v[j][1] * v[j][1]) + (v[j][2] * v[j][2] + v[j][3] * v[j][3]); }
            q = wave_sum(q);
            if (lane < 32) ss[(size_t)m * 32 + lane] = (lane == 0) ? q : 0.f;
        } }
    { const GAS f32x4* p = (const GAS f32x4*)A.in[1]; GAS v4u* o = (GAS v4u*)(F.ws + WS_PBF); const size_t n8 = (size_t)DEPTH * M * PLE / 8;
        const size_t st = (size_t)F.NGW * 64;
        for (size_t i = (size_t)F.gw * 64 + lane; i < n8; i += 4 * st) { f32x4 a[4], b[4];
#pragma unroll
            for (int j = 0; j < 4; ++j) if (i + j * st < n8) { a[j] = __builtin_nontemporal_load(p + 2 * (i + j * st)); b[j] = __builtin_nontemporal_load(p + 2 * (i + j * st) + 1); }
#pragma unroll
            for (int j = 0; j < 4; ++j) if (i + j * st < n8) { v4u w; w.x = cvt_pk_bf16(a[j][0], a[j][1]); w.y = cvt_pk_bf16(a[j][2], a[j][3]); w.z = cvt_pk_bf16(b[j][0], b[j][1]); w.w = cvt_pk_bf16(b[j][2], b[j][3]); o[i + j * st] = w; } } }
    { bf16* wsb = (bf16*)(F.ws + WS_WSB); bf16* pwt = (bf16*)(F.ws + WS_PWT); const int n = DEPTH * 4 * 128 * 128;
        for (int i = F.gw * 64 + lane; i < n; i += F.NGW * 64) {
            const int s = i & 127, t = (i >> 7) & 127;
            wsb[i] = f2bf((s <= t) ? A.in[6][i] : 0.f);
            const int c = i & 127, d = (i >> 7) & 127, lg = i >> 14;
            pwt[i] = f2bf(A.in[13][((size_t)lg * 128 + c) * 128 + d] * A.in[14][lg * 128 + d]);
        } }
}

__device__ __forceinline__ void mixer_shortconv(const Frame& F, const Args& A, int l, int chunk, const bf16* Z, bf16* MIX) {
    const int lane = lane_opaque();
    const int c8 = lane * 8, row0 = chunk * 128, pos0 = (chunk & 31) * 128, t0 = F.wave * 16;
    const float* cw = A.in[8] + (size_t)l * 3 * GW;
    float w0[8], w1[8], w2[8];
#pragma unroll
    for (int j = 0; j < 8; ++j) { w0[j] = cw[c8 + j]; w1[j] = cw[GW + c8 + j]; w2[j] = cw[2 * GW + c8 + j]; }
    float xm2[8], xm1[8];
#pragma unroll
    for (int j = 0; j < 8; ++j) { xm2[j] = 0.f; xm1[j] = 0.f; }
#pragma unroll
    for (int dt = -2; dt < 16; ++dt) {
        const int t = t0 + dt; const bool valid = (pos0 + t) >= 0;
        const bf16* zr = Z + (size_t)(row0 + (valid ? t : 0)) * ZC;
        float xv[8], x[8];
        unpack8(*(const GAS v4u*)(zr + 1024 + c8), xv);
#pragma unroll
        for (int j = 0; j < 8; ++j) x[j] = valid ? xv[j] : 0.f;
        if (dt >= 0) { float bg[8], o[8]; unpack8(*(const GAS v4u*)(zr + 1536 + c8), bg);
#pragma unroll
            for (int j = 0; j < 8; ++j) o[j] = bg[j] * (w0[j] * xm2[j] + w1[j] * xm1[j] + w2[j] * x[j]);
            *(GAS v4u*)(MIX + (size_t)(row0 + t) * D + 512 + c8) = pack8(o); }
#pragma unroll
        for (int j = 0; j < 8; ++j) { xm2[j] = xm1[j]; xm1[j] = x[j]; }
    }
}
template <int SH> __device__ __forceinline__ float row_shr(float v) { return __int_as_float(__builtin_amdgcn_update_dpp(0, __float_as_int(v), 0x110 + SH, 0xf, 0xf, true)); }
template <int SH> __device__ __forceinline__ float row_shl(float v) { return __int_as_float(__builtin_amdgcn_update_dpp(0, __float_as_int(v), 0x100 + SH, 0xf, 0xf, true)); }
template <int S> __device__ __forceinline__ void win_step(float (&c)[8], float (&p)[8]) {
#pragma unroll
    for (int j = 0; j < 8; ++j) { const float cn = c[j] + row_shr<S>(c[j]) + row_shl<16 - S>(p[j]); p[j] += row_shr<S>(p[j]); c[j] = cn; }
}
template <int W> __device__ __forceinline__ void pool_group(const bf16* zrow  , const bf16* pw  , bf16* orow  , int pos, bool prev_ok) {
    const float inv = 1.0f / (float)((pos + 1) < W ? (pos + 1) : W);
    f32x4 acc[8];
#pragma unroll
    for (int dt = 0; dt < 8; ++dt) acc[dt] = (f32x4){0.f, 0.f, 0.f, 0.f};
    v4u cw[4], pv[4], aw[2][8];
#pragma unroll
    for (int kk = 0; kk < 4; ++kk) { cw[kk] = *(const GAS v4u*)(zrow + 32 * kk); pv[kk] = prev_ok ? *(const GAS v4u*)(zrow + 32 * kk - (ptrdiff_t)16 * ZC) : (v4u){0u, 0u, 0u, 0u}; }
#pragma unroll
    for (int dt = 0; dt < 8; ++dt) aw[0][dt] = *(const GAS v4u*)(pw + (size_t)16 * dt * 128);
#pragma unroll
    for (int kk = 0; kk < 4; ++kk) {
        if (kk < 3) {
#pragma unroll
            for (int dt = 0; dt < 8; ++dt) aw[(kk + 1) & 1][dt] = *(const GAS v4u*)(pw + (size_t)16 * dt * 128 + 32 * (kk + 1)); }
        float own[8], c[8], p[8];
        unpack8(cw[kk], own); unpack8(pv[kk], p);
#pragma unroll
        for (int j = 0; j < 8; ++j) c[j] = own[j];
        win_step<1>(c, p);
        if (W >= 4) win_step<2>(c, p);
        if (W >= 8) win_step<4>(c, p);
        if (W >= 16) win_step<8>(c, p);
        float pl[8];
#pragma unroll
        for (int j = 0; j < 8; ++j) pl[j] = c[j] * inv - own[j];
        const v4u pwk = pack8(pl); const bf16x8 pf = __builtin_bit_cast(bf16x8, pwk);
#pragma unroll
        for (int dt = 0; dt < 8; ++dt) acc[dt] = __builtin_amdgcn_mfma_f32_16x16x32_bf16(__builtin_bit_cast(bf16x8, aw[kk & 1][dt]), pf, acc[dt], 0, 0, 0);
    }
#pragma unroll
    for (int dt = 0; dt < 8; ++dt) { v2u w; w.x = cvt_pk_bf16(acc[dt][0], acc[dt][1]); w.y = cvt_pk_bf16(acc[dt][2], acc[dt][3]); *(GAS v2u*)(orow + 16 * dt) = w; }
}
__device__ __forceinline__ void mixer_pool(const Frame& F, int l, int chunk, const bf16* Z, bf16* MIX) {
    const int lane = lane_opaque();
    const int i = lane & 15, g4 = lane >> 4, t = F.wave * 16 + i, row = chunk * 128 + t, pos = (chunk & 31) * 128 + t;
    const bool prev_ok = ((chunk & 31) * 128 + F.wave * 16) > 0;
    const bf16* pwt = (const bf16*)(F.ws + WS_PWT) + (size_t)l * 4 * 128 * 128 + (size_t)i * 128 + 8 * g4;
    const bf16* zrow = Z + (size_t)row * ZC + 2560 + 8 * g4; bf16* orow = MIX + (size_t)row * D + 1536 + 4 * g4;
    pool_group<2>(zrow, pwt, orow, pos, prev_ok);
    pool_group<4>(zrow + 128, pwt + 128 * 128, orow + 128, pos, prev_ok);
    pool_group<8>(zrow + 256, pwt + 2 * 128 * 128, orow + 256, pos, prev_ok);
    pool_group<16>(zrow + 384, pwt + 3 * 128 * 128, orow + 384, pos, prev_ok);
}
constexpr int VT_STRIDE = 136;
__device__ __forceinline__ void mixer_sgu(const Frame& F, const Args& A, int l, int chunk, const bf16* Z, bf16* MIX) {
    const int lane = lane_opaque(), tid = F.wave * 64 + lane;
    const int row0 = chunk * 128;
    const bf16* wsb = (const bf16*)(F.ws + WS_WSB) + (size_t)l * 4 * 128 * 128;
    const int t1 = tid >> 2, q = tid & 3, i = lane & 15, g4 = lane >> 4, w = F.wave, t2 = 16 * w + i, kkmax = w >> 1;
    const bf16* zv = Z + (size_t)(row0 + t1) * ZC + 512 + 32 * q;
    const bf16* zu = Z + (size_t)(row0 + t2) * ZC + 4 * g4;
    bf16* mo = MIX + (size_t)(row0 + t2) * D + 4 * g4;
    v4u vr[4];
#pragma unroll
    for (int j = 0; j < 4; ++j) vr[j] = *(const GAS v4u*)(zv + 8 * j);
#pragma unroll 1
    for (int hd = 0; hd < 4; ++hd) {
        LAS bf16* VT = (LAS bf16*)(F.lds + (hd & 1) * (128 * VT_STRIDE * 2));
        {
            const float* lg = A.in[4] + (size_t)(l * 4 + hd) * 128 + 32 * q; const float* lb = A.in[5] + (size_t)(l * 4 + hd) * 128 + 32 * q;
            f32x4 g4v[8], b4v[8];
#pragma unroll
            for (int j = 0; j < 8; ++j) { g4v[j] = *(const GAS f32x4*)(lg + 4 * j); b4v[j] = *(const GAS f32x4*)(lb + 4 * j); }
            float v[32];
#pragma unroll
            for (int j = 0; j < 4; ++j) { float f[8]; unpack8(vr[j], f);
#pragma unroll
                for (int e = 0; e < 8; ++e) v[8 * j + e] = f[e]; }
            float s = 0.f;
#pragma unroll
            for (int j = 0; j < 32; ++j) s += v[j];
            s = pg8::sum_xor1_2(s);
            const float mean = s * (1.0f / 128.0f); float s2 = 0.f;
#pragma unroll
            for (int j = 0; j < 32; ++j) { v[j] -= mean; s2 += v[j] * v[j]; }
            s2 = pg8::sum_xor1_2(s2);
            const float rstd = __builtin_amdgcn_rsqf(s2 * (1.0f / 128.0f) + EPS);
#pragma unroll
            for (int j = 0; j < 32; ++j) { const float y = v[j] * rstd * g4v[j >> 2][j & 3] + b4v[j >> 2][j & 3]; VT[(32 * q + j) * VT_STRIDE + t1] = f2bf(y); }
        }
        if (hd < 3) {
#pragma unroll
            for (int j = 0; j < 4; ++j) vr[j] = *(const GAS v4u*)(zv + 128 * (hd + 1) + 8 * j); }
        bf16x8 bfrag[4];
#pragma unroll
        for (int kk = 0; kk < 4; ++kk) { v4u bw = (v4u){0u, 0u, 0u, 0u}; if (kk <= kkmax) bw = *(const GAS v4u*)(wsb + ((size_t)hd * 128 + t2) * 128 + 32 * kk + 8 * g4); bfrag[kk] = __builtin_bit_cast(bf16x8, bw); }
        const float bs = A.in[7][(size_t)(l * 4 + hd) * 128 + t2];
        v2u uw[8];
#pragma unroll
        for (int dt = 0; dt < 8; ++dt) uw[dt] = *(const GAS v2u*)(zu + 128 * hd + 16 * dt);
        __syncthreads();
#pragma unroll
        for (int dt = 0; dt < 8; ++dt) {
            f32x4 acc = (f32x4){0.f, 0.f, 0.f, 0.f};
#pragma unroll
            for (int kk = 0; kk < 4; ++kk) if (kk <= kkmax) { const bf16x8 af = *(const LAS bf16x8*)(VT + (16 * dt + i) * VT_STRIDE + 32 * kk + 8 * g4);
                acc = __builtin_amdgcn_mfma_f32_16x16x32_bf16(af, bfrag[kk], acc, 0, 0, 0); }
            v2u o; o.x = cvt_pk_bf16(bf_lo(uw[dt].x) * (acc[0] + bs), bf_hi(uw[dt].x) * (acc[1] + bs)); o.y = cvt_pk_bf16(bf_lo(uw[dt].y) * (acc[2] + bs), bf_hi(uw[dt].y) * (acc[3] + bs));
            *(GAS v2u*)(mo + 128 * hd + 16 * dt) = o;
        }
    }
    __syncthreads();
}
__device__ __forceinline__ f32x2 glu_pair(const bf16* zr) {
    const unsigned hw = *(const GAS unsigned*)(zr + 2048);
    f32x2 hh; hh.x = bf_lo(hw); hh.y = bf_hi(hw); return hh;
}
__device__ __forceinline__ void mixer_conformer(const Frame& F, const Args& A, int l, int chunk, const bf16* Z, bf16* MIX) {
    const int lane = lane_opaque(), tid = F.wave * 64 + lane;
    const int row0 = chunk * 128, pos0 = (chunk & 31) * 128;
    LAS unsigned char* ybuf = F.lds;
    {
        const int cp = tid & 255, s2 = F.wave >> 2, c0 = 2 * cp;
        const float* cw = A.in[9] + (size_t)l * CONVK * GW + c0;
        f32x2 wk[CONVK];
#pragma unroll
        for (int k = 0; k < CONVK; ++k) wk[k] = *(const GAS f32x2*)(cw + (size_t)k * GW);
        const f32x2 bias = *(const GAS f32x2*)(A.in[10] + (size_t)l * GW + c0);
        f32x2 win[32];
        const bf16* zp = Z + (size_t)(row0 + 64 * s2) * ZC + c0;
        if (pos0 + 64 * s2 > 0) {
#pragma unroll
            for (int r = 0; r < 32; ++r) win[r] = glu_pair(zp - (ptrdiff_t)(32 - r) * ZC);
        } else {
#pragma unroll
            for (int r = 0; r < 32; ++r) win[r] = (f32x2){0.f, 0.f};
        }
#pragma unroll 1
        for (int rd = 0; rd < 2; ++rd) {
            unsigned raw[32];
#pragma unroll
            for (int r = 0; r < 32; ++r) raw[r] = *(const GAS unsigned*)(zp + (size_t)r * ZC + 2048);
#pragma unroll
            for (int r = 0; r < 32; ++r) {
                win[r] = (f32x2){bf_lo(raw[r]), bf_hi(raw[r])};
                f32x2 y = bias;
#pragma unroll
                for (int k = 0; k < CONVK; ++k) y += wk[k] * win[(r + 2 + k) & 31];
                *(LAS unsigned*)(ybuf + (size_t)(64 * s2 + 32 * rd + r) * 1024 + cp * 4) = cvt_pk_bf16(y.x, y.y);
            }
            zp += (size_t)32 * ZC;
        }
    }
    __syncthreads();
    {
        const int c8 = lane * 8;
        float lg[8], lb[8];
#pragma unroll
        for (int j = 0; j < 8; ++j) { lg[j] = A.in[11][(size_t)l * GW + c8 + j]; lb[j] = A.in[12][(size_t)l * GW + c8 + j]; }
#pragma unroll 2
        for (int tt = 0; tt < 16; ++tt) {
            const int t = F.wave * 16 + tt;
            float v[8]; unpack8(*(const LAS v4u*)(ybuf + (size_t)t * 1024 + lane * 16), v);
            float s = 0.f;
#pragma unroll
            for (int j = 0; j < 8; ++j) s += v[j];
            const float mean = wave_sum(s) * (1.0f / 512.0f); float q = 0.f;
#pragma unroll
            for (int j = 0; j < 8; ++j) { v[j] -= mean; q += v[j] * v[j]; }
            const float rstd = __builtin_amdgcn_rsqf(wave_sum(q) * (1.0f / 512.0f) + EPS);
            float o[8];
#pragma unroll
            for (int j = 0; j < 8; ++j) o[j] = silu_f(v[j] * rstd * lg[j] + lb[j]);
            *(GAS v4u*)(MIX + (size_t)(row0 + t) * D + 1024 + c8) = pack8(o);
        }
    }
    __syncthreads();
}

__global__ void __launch_bounds__(NTHR, 2) trunk_fwd(Args args) {
    extern __shared__ __attribute__((aligned(16))) unsigned char lds[];
    Frame F;
    F.lds = (LAS unsigned char*)lds;
    F.wave = __builtin_amdgcn_readfirstlane(threadIdx.x >> 6);
    F.G = gridDim.x; F.gw = blockIdx.x * NWAVES + F.wave; F.NGW = F.G * NWAVES;
    F.out = (GAS float*)args.out; F.ws = (GAS unsigned char*)args.ws;
    volatile LAS unsigned* MISC = (volatile LAS unsigned*)(F.lds + MISC_OFF);
    { const int tid0 = F.wave * 64 + lane_opaque();
      for (int u = tid0; u < (LDS_BYTES - LDSCTL_OFF) / 4; u += NTHR) ((LAS unsigned*)(F.lds + LDSCTL_OFF))[u] = 0u; }
    __syncthreads();
    unsigned* barw = (unsigned*)((unsigned char*)args.ws + WS_CTL) + CW_BAR;
    XcdBarrier bar; bar.bar = barw; bar.x = 0; bar.st = nullptr; bar.wave = F.wave;
    const int lo = args.ph_lo, hi = args.ph_hi;
    if (hi - lo > 1) bar = xcd_barrier_post(barw, MISC + 8, F.wave);
#define IN(k) (lo <= (k) && (k) < hi)
#define SEAM(k) do { if (IN(k) && IN((k) + 1)) xcd_barrier(bar); } while (0)

    if (IN(0)) { const Frame P = phase_frame(F); for (int rep = 0; rep < ((PROBE_DUP >> 6) & 1) + 1; ++rep) p0_prologue(P, args); }
    SEAM(0);

#define PHASE_PTRS const Frame P = phase_frame(F); const int bid = P.gw >> 3; \
    const unsigned char* const wl = (const unsigned char*)(P.ws + WS_W + (size_t)l * W_LAYER); bf16* const HBc = (bf16*)(P.ws + ((l & 1) ? WS_HB1 : WS_HB0)); bf16* const HBn = (bf16*)(P.ws + ((l & 1) ? WS_HB0 : WS_HB1)); \
    bf16* const Z = (bf16*)(P.ws + WS_Z); bf16* const MIX = (bf16*)(P.ws + WS_MIX); bf16* const T = (bf16*)(P.ws + WS_T); bf16* const PP = (bf16*)P.out;     \
    float* const SS0 = (float*)(P.ws + WS_SS); float* const SS1 = (float*)(P.ws + WS_SS + SS_BYTES); float* const SS2 = (float*)(P.ws + WS_SS + 2 * SS_BYTES); \
    (void)bid; (void)wl; (void)HBc; (void)HBn; (void)Z; (void)MIX; (void)T; (void)PP; (void)SS0; (void)SS1; (void)SS2;

#pragma unroll 1
    for (int l = 0; l < DEPTH; ++l) {
        const int pb = 1 + 6 * l;
        if (IN(pb + 0)) { PHASE_PTRS
            pg8::Gemm g{HBc, (const bf16*)(wl + WO_IN), M, INC, D}; pg8::StaticOrder S; S.init(M, INC, P.G, bid, 4);
            pg8::EpiG1 E{Z, SS0};
            for (int rep = 0; rep < ((PROBE_DUP >> 0) & 1) + 1; ++rep)
            pg8::gemm_phase<pg8::EpiG1, pg8::StaticOrder, true, true>(P.lds, g, S, E, P.wave);
        }
        SEAM(pb + 0);
        if (IN(pb + 1)) { PHASE_PTRS
            for (int chunk_ = bid; chunk_ < (M / 128) * (((PROBE_DUP >> 1) & 1) + 1); chunk_ += P.G) { const int cq = chunk_ & (M / 128 - 1), chunk = (P.G == 256) ? ((cq & 7) * 32 + (cq >> 3)) : cq;
                mixer_shortconv(P, args, l, chunk, Z, MIX);
                if ((PROBE_DUP >> 8) & 1) mixer_shortconv(P, args, l, chunk, Z, MIX);
                mixer_pool(P, l, chunk, Z, MIX);
                if ((PROBE_DUP >> 9) & 1) mixer_pool(P, l, chunk, Z, MIX);
                mixer_sgu(P, args, l, chunk, Z, MIX);
                if ((PROBE_DUP >> 10) & 1) mixer_sgu(P, args, l, chunk, Z, MIX);
                mixer_conformer(P, args, l, chunk, Z, MIX);
                if ((PROBE_DUP >> 11) & 1) mixer_conformer(P, args, l, chunk, Z, MIX);
            }
        }
        SEAM(pb + 1);
        if (IN(pb + 2)) { PHASE_PTRS
            pg8::Gemm g{MIX, (const bf16*)(wl + WO_OUT), M, D, D}; pg8::StaticOrder S; S.init(M, D, P.G, bid, 4);
            pg8::EpiRes E{HBc, SS1};
            pg8::gemm_phase<pg8::EpiRes, pg8::StaticOrder, true, true>(P.lds, g, S, E, P.wave);
            if ((PROBE_DUP >> 2) & 1) { pg8::EpiRes E2{HBn, SS2}; pg8::gemm_phase<pg8::EpiRes, pg8::StaticOrder, true, true>(P.lds, g, S, E2, P.wave); }
        }
        SEAM(pb + 2);
        if (IN(pb + 3)) { PHASE_PTRS
            pg8::Gemm g{HBc, (const bf16*)(wl + WO_GU), M, 2 * FF, D}; pg8::StaticOrder S; S.init(M, 2 * FF, P.G, bid);
            pg8::EpiSwiGLU E{T, FF, SS1};
            for (int rep = 0; rep < (((PROBE_DUP >> 3) | (PROBE_DUP >> 7)) & 1) + 1; ++rep) {
            if ((PROBE_DUP >> 7) & 1) S.fixed = (rep == 0);
            pg8::gemm_phase<pg8::EpiSwiGLU, pg8::StaticOrder, true, true>(P.lds, g, S, E, P.wave); }
        }
        SEAM(pb + 3);
        if (IN(pb + 4)) { PHASE_PTRS
            pg8::Gemm g{T, (const bf16*)(wl + WO_D), M, D, FF}; pg8::StaticOrder S; S.init(M, D, P.G, bid, 4); S.rev = 1;
            pg8::EpiRes E{HBc, SS2};
            pg8::gemm_phase<pg8::EpiRes, pg8::StaticOrder, true, true>(P.lds, g, S, E, P.wave);
            if ((PROBE_DUP >> 4) & 1) { pg8::EpiRes E2{HBn, SS0}; pg8::gemm_phase<pg8::EpiRes, pg8::StaticOrder, true, true>(P.lds, g, S, E2, P.wave); }
        }
        if (IN(pb + 4)) { PHASE_PTRS
            { pg8::Gemm g{(const bf16*)(P.ws + WS_PBF) + (size_t)l * M * PLE, (const bf16*)(wl + WO_PP), M, D, PLE}; pg8::StaticOrder S; S.init(M, D, P.G, bid, 4);
              pg8::EpiStore<false> E{PP, D, nullptr};
              pg8::gemm_phase<pg8::EpiStore<false>, pg8::StaticOrder, true, true>(P.lds, g, S, E, P.wave); }
        }
        SEAM(pb + 4);
        if (IN(pb + 5)) { PHASE_PTRS
            for (int rep = 0; rep < ((PROBE_DUP >> 5) & 1) + 1; ++rep) {
            { pg8::Gemm g{HBc, (const bf16*)(wl + WO_PG), M, D, D}; pg8::StaticOrder S; S.init(M, D, P.G, bid, 4);
              pg8::EpiPle E{HBc, HBn, PP, SS0, SS2};
              pg8::gemm_phase<pg8::EpiPle, pg8::StaticOrder, true, true>(P.lds, g, S, E, P.wave); }
            }
        }
        SEAM(pb + 5);
    }
    if (IN(NPHASE - 1)) {
        const Frame P = phase_frame(F);
        const int lane = lane_opaque();
        const float* fg = args.in[23];
        const bf16* HBf = (const bf16*)(P.ws + ((DEPTH & 1) ? WS_HB1 : WS_HB0));
        f32x4 gv[4][2];
#pragma unroll
        for (int j = 0; j < 4; ++j) { gv[j][0] = *(const GAS f32x4*)(fg + 512 * j + 8 * lane); gv[j][1] = *(const GAS f32x4*)(fg + 512 * j + 8 * lane + 4); }
        for (int m = P.gw; m < M; m += P.NGW) {
            const bf16* hr = HBf + (size_t)m * D + 8 * lane; float* orow = (float*)P.out + (size_t)m * D + 8 * lane;
            float v[4][8]; float q = 0.f;
#pragma unroll
            for (int j = 0; j < 4; ++j) { unpack8(*(const GAS v4u*)(hr + 512 * j), v[j]);
#pragma unroll
                for (int e = 0; e < 8; ++e) q += v[j][e] * v[j][e]; }
            const float rs = __builtin_amdgcn_rsqf(wave_sum(q) * (1.0f / D) + EPS);
#pragma unroll
            for (int j = 0; j < 4; ++j) { f32x4 o0, o1;
#pragma unroll
                for (int e = 0; e < 4; ++e) { o0[e] = v[j][e] * rs * gv[j][0][e]; o1[e] = v[j][4 + e] * rs * gv[j][1][e]; }
                *(GAS f32x4*)(orow + 512 * j) = o0; *(GAS f32x4*)(orow + 512 * j + 4) = o1; }
        }
    }
#undef IN
#undef SEAM
}

extern "C" void kernel_launch(void* const* d_in, const int* in_sizes, int n_in, void* d_out, int out_size, void* d_ws, size_t ws_size, hipStream_t stream) {
    static int grid = 0;
    if (grid == 0) {
        if (n_in != 24 || in_sizes[0] != M * D || out_size != M * D || ws_size < WS_END) {
            fprintf(stderr, "kernel_launch: built for 24 inputs, x/out of %d floats, >= %zu bytes of workspace; got n_in %d, in0 %d, out %d, ws %zu; nothing launched\n", M * D, (size_t)WS_END, n_in, n_in > 0 ? in_sizes[0] : -1, out_size, ws_size);
            grid = -1; return; }
        int dev = 0, cus = 0, per_cu = 0;
        if (hipGetDevice(&dev) != hipSuccess || hipDeviceGetAttribute(&cus, hipDeviceAttributeMultiprocessorCount, dev) != hipSuccess) { fprintf(stderr, "kernel_launch: device query failed\n"); grid = -1; return; }
        if (hipFuncSetAttribute((const void*)trunk_fwd, hipFuncAttributeMaxDynamicSharedMemorySize, LDS_BYTES) != hipSuccess) { fprintf(stderr, "kernel_launch: hipFuncSetAttribute failed\n"); grid = -1; return; }
        if (hipOccupancyMaxActiveBlocksPerMultiprocessor(&per_cu, (const void*)trunk_fwd, NTHR, LDS_BYTES) != hipSuccess || per_cu < 1) { fprintf(stderr, "kernel_launch: occupancy query says %d blocks per CU; nothing launched\n", per_cu); (void)hipGetLastError(); grid = -1; return; }
        grid = cus;
    }
    if (grid < 0) return;
    (void)hipMemsetAsync((char*)d_ws + WS_CTL, 0, CTL_ZERO_BYTES, stream);
    Args a{};
    for (int i = 0; i < 24; ++i) a.in[i] = (const float*)d_in[i];
    a.out = (float*)d_out; a.ws = (unsigned char*)d_ws;
#if MK_N_LAUNCHES == 1
    a.ph_lo = 0; a.ph_hi = NPHASE;
    hipLaunchKernelGGL(trunk_fwd, dim3(grid), dim3(NTHR), LDS_BYTES, stream, a);
#else
    for (int ph = 0; ph < NPHASE; ++ph) { a.ph_lo = ph; a.ph_hi = ph + 1; hipLaunchKernelGGL(trunk_fwd, dim3(grid), dim3(NTHR), LDS_BYTES, stream, a); }
#endif
    const hipError_t le = hipPeekAtLastError();
    if (le != hipSuccess) fprintf(stderr, "kernel_launch: launch failed: %s\n", hipGetErrorName(le));
}
```
